# Optimizing an MI355X kernel written in HIP

```python
import math
import jax, jax.numpy as jnp
from jax import lax
import numpy as np

D_MODEL = 1024
BATCH = 8
SEQ = 4096
DEPTH = 4

CHUNK = 64
Q_BLOCK = 128
EPS = 1e-6
NEG_INF = -1e30
D_MIX = D_MODEL
HEAD_DIM = 64
W_SSM = D_MIX // 4
W_SB = D_MIX // 4
W_CH = D_MIX // 4
W_DF = D_MIX - W_SSM - W_SB - W_CH
SSM_GROUP = 16
SSM_GROUPS = W_SSM // SSM_GROUP
SSM_STATE = 64
DT_MIN = 1e-3
DT_MAX = 1e-1
H_SB = W_SB // HEAD_DIM
H_CH = W_CH // HEAD_DIM
H_DF = W_DF // HEAD_DIM
DF_QK_DIM = HEAD_DIM // 2
CH_LEFT_CHUNKS = 8
CH_BAND = CH_LEFT_CHUNKS + 1
REL_CLIP = 128
N_MIX_HEADS = D_MIX // HEAD_DIM
IN_COLS = W_SSM + 3 * W_SB + 3 * W_CH + 3 * W_DF
D_FF = 11 * D_MODEL // 4
N_EXPERTS = 8
TOP_K = 2
D_FF_EXPERT = 7 * D_MODEL // 2
N_DENSE = (DEPTH + 1) // 2
N_MOE = DEPTH // 2

kernel_name = 'hybrid_parallel_heads_streaming_block'


def rms_norm(x, gain):
    xf = x.astype(jnp.float32)
    y = xf * lax.rsqrt(jnp.mean(xf * xf, axis=-1, keepdims=True) + EPS)
    return (y * gain.astype(jnp.float32)).astype(x.dtype)


def split_columns(proj):
    sizes = (W_SSM, W_SB, W_SB, W_SB, W_CH, W_CH, W_CH, W_DF, W_DF, W_DF)
    parts, off = [], 0
    for w in sizes:
        parts.append(proj[..., off:off + w])
        off += w
    return parts


def s5_mixer(u, lam_re, lam_im, log_dt, b_re, b_im, c_re, c_im, d_skip, w_glu, b_glu):
    bsz, seq, _ = u.shape
    f32 = jnp.float32
    uf = u.astype(f32).reshape(bsz, seq, SSM_GROUPS, SSM_GROUP)
    lam = lax.complex(lam_re.astype(f32), lam_im.astype(f32))
    dt = jnp.exp(log_dt.astype(f32))[:, None]
    lam_bar = jnp.exp(lam * dt)
    b_mat = lax.complex(b_re.astype(f32), b_im.astype(f32))
    c_mat = lax.complex(c_re.astype(f32), c_im.astype(f32))
    b_bar = ((lam_bar - 1.0) / lam)[..., None] * b_mat
    bu = jnp.einsum('bsgp,gnp->sbgn', uf.astype(jnp.complex64), b_bar)
    a = jnp.broadcast_to(lam_bar, (seq, 1) + lam_bar.shape)

    def combine(e1, e2):
        a1, b1 = e1
        a2, b2 = e2
        return a1 * a2, a2 * b1 + b2

    _, states = lax.associative_scan(combine, (a, bu), axis=0)
    y = jnp.einsum('sbgn,gpn->bsgp', states, c_mat).real + d_skip.astype(f32).reshape(SSM_GROUPS, SSM_GROUP) * uf
    y = jax.nn.gelu(y.reshape(bsz, seq, W_SSM))
    y = y * jax.nn.sigmoid(y @ w_glu + b_glu)
    return y.astype(u.dtype)


def stick_breaking_attention(q, k, v):
    bsz, seq, h, d = q.shape
    nb = seq // Q_BLOCK
    scale = d ** -0.5
    q_blocks = jnp.moveaxis(q.reshape(bsz, nb, Q_BLOCK, h, d), 1, 0)
    key_pos = jnp.arange(seq)

    def block(args):
        qb, bi = args
        q_pos = bi * Q_BLOCK + jnp.arange(Q_BLOCK)
        z = jnp.einsum('bqhd,bkhd->bhqk', qb, k).astype(jnp.float32) * scale
        before = key_pos[None, :] < q_pos[:, None]
        log_1m = jnp.where(before, jax.nn.log_sigmoid(-z), 0.0)
        between = lax.cumsum(log_1m, axis=3, reverse=True) - log_1m
        w = jnp.where(before, jnp.exp(jax.nn.log_sigmoid(z) + between), 0.0)
        return jnp.einsum('bhqk,bkhd->bqhd', w.astype(v.dtype), v)

    out = lax.map(block, (q_blocks, jnp.arange(nb)))
    return jnp.moveaxis(out, 0, 1).reshape(bsz, seq, h * d)


def chunked_band_attention(q, k, v, rel_bias):
    bsz, seq, h, d = q.shape
    nc = seq // CHUNK
    scale = d ** -0.5
    qc = q.reshape(bsz, nc, CHUNK, h, d)
    pad = ((0, 0), (CH_LEFT_CHUNKS * CHUNK, 0), (0, 0), (0, 0))
    kp = jnp.pad(k, pad).reshape(bsz, nc + CH_LEFT_CHUNKS, CHUNK, h, d)
    vp = jnp.pad(v, pad).reshape(bsz, nc + CH_LEFT_CHUNKS, CHUNK, h, d)
    band_idx = jnp.arange(nc)[:, None] + jnp.arange(CH_BAND)[None, :]
    kb = kp[:, band_idx].reshape(bsz, nc, CH_BAND * CHUNK, h, d)
    vb = vp[:, band_idx].reshape(bsz, nc, CH_BAND * CHUNK, h, d)
    key_valid = jnp.repeat(band_idx >= CH_LEFT_CHUNKS, CHUNK, axis=1)
    rel = CH_LEFT_CHUNKS * CHUNK + jnp.arange(CHUNK)[:, None] - jnp.arange(CH_BAND * CHUNK)[None, :]
    bias = rel_bias.astype(jnp.float32)[:, jnp.clip(rel, -REL_CLIP, REL_CLIP) + REL_CLIP]
    s = jnp.einsum('bcqhd,bckhd->bhcqk', qc, kb).astype(jnp.float32) * scale + bias[:, None]
    s = jnp.where(key_valid[:, None, :], s, NEG_INF)
    p = jax.nn.softmax(s, axis=-1)
    out = jnp.einsum('bhcqk,bckhd->bcqhd', p.astype(v.dtype), vb)
    return out.reshape(bsz, seq, h * d)


def differential_attention(q, k, v, lam, slopes):
    bsz, seq, h, _, dq = q.shape
    nb = seq // Q_BLOCK
    scale = dq ** -0.5
    q_blocks = jnp.moveaxis(q.reshape(bsz, nb, Q_BLOCK, h, 2, dq), 1, 0)
    key_pos = jnp.arange(seq)

    def block(args):
        qb, bi = args
        q_pos = bi * Q_BLOCK + jnp.arange(Q_BLOCK)
        s = jnp.einsum('bqhid,bkhid->ibhqk', qb, k).astype(jnp.float32) * scale
        dist = jnp.abs(q_pos[:, None] - key_pos[None, :]).astype(jnp.float32)
        s = s - slopes[:, None, None] * dist
        allowed = (key_pos[None, :] // CHUNK) <= (q_pos[:, None] // CHUNK)
        p = jax.nn.softmax(jnp.where(allowed, s, NEG_INF), axis=-1)
        w = p[0] - lam * p[1]
        return jnp.einsum('bhqk,bkhd->bqhd', w.astype(v.dtype), v)

    out = lax.map(block, (q_blocks, jnp.arange(nb)))
    return jnp.moveaxis(out, 0, 1).reshape(bsz, seq, h * v.shape[-1])


def swiglu(h, w1, w3, w2):
    return (jax.nn.silu(h @ w1) * (h @ w3)) @ w2


def moe_ffn(h, w_router, w1, w3, w2):
    bsz, seq, dm = h.shape
    tok = h.reshape(bsz * seq, dm)
    logits = (tok @ w_router).astype(jnp.float32)
    top_vals, top_idx = lax.top_k(logits, TOP_K)
    gates = jax.nn.softmax(top_vals, axis=-1)
    dense_gate = jnp.sum(jax.nn.one_hot(top_idx, N_EXPERTS, dtype=jnp.float32) * gates[..., None], axis=1)
    out = jnp.zeros_like(tok)
    for e in range(N_EXPERTS):
        out = out + dense_gate[:, e:e + 1].astype(tok.dtype) * swiglu(tok, w1[e], w3[e], w2[e])
    return out.reshape(bsz, seq, dm)


def setup_inputs(seed: int = 0) -> dict:
    key = jax.random.key(seed)
    ks = iter(jax.random.split(key, 40))
    f32 = jnp.float32

    def nrm(shape, scale):
        return scale * jax.random.normal(next(ks), shape, f32)

    def gain(shape):
        return 1.0 + 0.05 * jax.random.normal(next(ks), shape, f32)

    res_scale = (2.0 * DEPTH) ** -0.5
    return {
        'x': nrm((BATCH, SEQ, D_MODEL), 1.0),
        'norm_mix_g': gain((DEPTH, D_MODEL)),
        'w_in': nrm((DEPTH, D_MODEL, IN_COLS), D_MODEL ** -0.5),
        'ssm_lam_re': -0.5 + nrm((DEPTH, SSM_GROUPS, SSM_STATE), 0.01),
        'ssm_lam_im': jnp.pi * jnp.arange(SSM_STATE, dtype=f32) + nrm((DEPTH, SSM_GROUPS, SSM_STATE), 0.01),
        'ssm_log_dt': jax.random.uniform(next(ks), (DEPTH, SSM_GROUPS), f32, math.log(DT_MIN), math.log(DT_MAX)),
        'ssm_b_re': nrm((DEPTH, SSM_GROUPS, SSM_STATE, SSM_GROUP), (2.0 * SSM_GROUP) ** -0.5),
        'ssm_b_im': nrm((DEPTH, SSM_GROUPS, SSM_STATE, SSM_GROUP), (2.0 * SSM_GROUP) ** -0.5),
        'ssm_c_re': nrm((DEPTH, SSM_GROUPS, SSM_GROUP, SSM_STATE), (2.0 * SSM_STATE) ** -0.5),
        'ssm_c_im': nrm((DEPTH, SSM_GROUPS, SSM_GROUP, SSM_STATE), (2.0 * SSM_STATE) ** -0.5),
        'ssm_d': nrm((DEPTH, W_SSM), 1.0),
        'ssm_w_glu': nrm((DEPTH, W_SSM, W_SSM), W_SSM ** -0.5),
        'ssm_b_glu': nrm((DEPTH, W_SSM), 0.02),
        'ch_q_norm_g': gain((DEPTH, HEAD_DIM)),
        'ch_k_norm_g': gain((DEPTH, HEAD_DIM)),
        'ch_rel_bias': nrm((DEPTH, H_CH, 2 * REL_CLIP + 1), 0.1),
        'df_q_norm_g': gain((DEPTH, 2, DF_QK_DIM)),
        'df_k_norm_g': gain((DEPTH, 2, DF_QK_DIM)),
        'df_lambda': nrm((DEPTH, 4, DF_QK_DIM), 0.1),
        'out_norm_g': gain((DEPTH, D_MIX)),
        'w_out': nrm((DEPTH, D_MIX, D_MODEL), D_MIX ** -0.5 * res_scale),
        'norm_ffn_g': gain((DEPTH, D_MODEL)),
        'ffn_w1': nrm((N_DENSE, D_MODEL, D_FF), D_MODEL ** -0.5),
        'ffn_w3': nrm((N_DENSE, D_MODEL, D_FF), D_MODEL ** -0.5),
        'ffn_w2': nrm((N_DENSE, D_FF, D_MODEL), D_FF ** -0.5 * res_scale),
        'moe_router': nrm((N_MOE, D_MODEL, N_EXPERTS), D_MODEL ** -0.5),
        'moe_w1': nrm((N_MOE, N_EXPERTS, D_MODEL, D_FF_EXPERT), D_MODEL ** -0.5),
        'moe_w3': nrm((N_MOE, N_EXPERTS, D_MODEL, D_FF_EXPERT), D_MODEL ** -0.5),
        'moe_w2': nrm((N_MOE, N_EXPERTS, D_FF_EXPERT, D_MODEL), D_FF_EXPERT ** -0.5 * res_scale),
    }


def reference(x, norm_mix_g, w_in, ssm_lam_re, ssm_lam_im, ssm_log_dt, ssm_b_re, ssm_b_im, ssm_c_re, ssm_c_im,
              ssm_d, ssm_w_glu, ssm_b_glu, ch_q_norm_g, ch_k_norm_g, ch_rel_bias, df_q_norm_g, df_k_norm_g,
              df_lambda, out_norm_g, w_out, norm_ffn_g, ffn_w1, ffn_w3, ffn_w2, moe_router, moe_w1, moe_w3, moe_w2):
    bsz, seq, _ = x.shape
    slopes = jnp.exp2(-8.0 * jnp.arange(1, H_DF + 1, dtype=jnp.float32) / H_DF)

    def heads(t, n):
        return t.reshape(bsz, seq, n, HEAD_DIM)

    for layer in range(DEPTH):
        h = rms_norm(x, norm_mix_g[layer])
        proj = h @ w_in[layer]
        u, q_sb, k_sb, v_sb, q_ch, k_ch, v_ch, q_df, k_df, v_df = split_columns(proj)

        y_ssm = s5_mixer(u, ssm_lam_re[layer], ssm_lam_im[layer], ssm_log_dt[layer], ssm_b_re[layer],
                         ssm_b_im[layer], ssm_c_re[layer], ssm_c_im[layer], ssm_d[layer],
                         ssm_w_glu[layer], ssm_b_glu[layer])

        y_sb = stick_breaking_attention(heads(q_sb, H_SB), heads(k_sb, H_SB), heads(v_sb, H_SB))

        q_c = rms_norm(heads(q_ch, H_CH), ch_q_norm_g[layer])
        k_c = rms_norm(heads(k_ch, H_CH), ch_k_norm_g[layer])
        y_ch = chunked_band_attention(q_c, k_c, heads(v_ch, H_CH), ch_rel_bias[layer])

        q_d = rms_norm(q_df.reshape(bsz, seq, H_DF, 2, DF_QK_DIM), df_q_norm_g[layer])
        k_d = rms_norm(k_df.reshape(bsz, seq, H_DF, 2, DF_QK_DIM), df_k_norm_g[layer])
        lambda_init = 0.8 - 0.6 * math.exp(-0.3 * layer)
        lam_p = df_lambda[layer].astype(jnp.float32)
        lam = jnp.exp(jnp.sum(lam_p[0] * lam_p[1])) - jnp.exp(jnp.sum(lam_p[2] * lam_p[3])) + lambda_init
        y_df = differential_attention(q_d, k_d, heads(v_df, H_DF), lam, slopes)

        mix = jnp.concatenate([y_ssm, y_sb, y_ch, y_df], axis=-1).reshape(bsz, seq, N_MIX_HEADS, HEAD_DIM)
        head_scale = jnp.concatenate([jnp.ones((N_MIX_HEADS - H_DF,), jnp.float32),
                                      jnp.full((H_DF,), 1.0 - lambda_init, jnp.float32)])
        mix = rms_norm(mix, out_norm_g[layer].reshape(N_MIX_HEADS, HEAD_DIM)) * head_scale[:, None].astype(x.dtype)
        x = x + mix.reshape(bsz, seq, D_MIX) @ w_out[layer]

        h2 = rms_norm(x, norm_ffn_g[layer])
        idx = layer // 2
        if layer % 2 == 0:
            x = x + swiglu(h2, ffn_w1[idx], ffn_w3[idx], ffn_w2[idx])
        else:
            x = x + moe_ffn(h2, moe_router[idx], moe_w1[idx], moe_w3[idx], moe_w2[idx])
    return x
```

```cpp
#include <hip/hip_runtime.h>
#include <cstdio>
#include <cstdint>

#define GAS __attribute__((address_space(1)))
#define LAS __attribute__((address_space(3)))
typedef unsigned short bf16;
typedef unsigned v4u __attribute__((ext_vector_type(4)));
typedef unsigned v2u __attribute__((ext_vector_type(2)));
typedef float f32x4 __attribute__((ext_vector_type(4)));
typedef float f32x2 __attribute__((ext_vector_type(2)));
typedef short bf16x8 __attribute__((ext_vector_type(8)));
typedef GAS unsigned gu32;

#ifndef MOE_FP8
#define MOE_FP8 1
#endif
#ifndef DENSE_FP8
#define DENSE_FP8 0
#endif
#ifndef DENSE_UP_I8
#define DENSE_UP_I8 1
#define WOUT_I8 1
#define WIN_I8 1
#endif
constexpr float ACT8 = 8.0f, WGT8 = 256.0f, INV8 = 1.0f / (ACT8 * WGT8);
constexpr int BATCH = 8, SEQ = 4096, DM = 1024, NTOK = BATCH * SEQ, DEPTH = 4;
constexpr int INC = 2560;
constexpr int C_U = 0, C_QSB = 256, C_KSB = 512, C_VSB = 768, C_QCH = 1024, C_KCH = 1280, C_VCH = 1536, C_QDF = 1792, C_KDF = 2048, C_VDF = 2304;
constexpr int DFF = 2816, NE = 8, DFE = 3584;
constexpr float EPS = 1e-6f;
constexpr int MOE_ROWS = 65536 + 8 * 256;

constexpr size_t MiB = 1u << 20;
constexpr size_t WS_CTL = 0, CTL_ZERO_BYTES = 1 * MiB;
constexpr size_t WS_WIN = 2 * MiB;
constexpr size_t WS_WOUT = 22 * MiB;
constexpr size_t WS_WFUP = 30 * MiB;
constexpr size_t WS_WFDN = 52 * MiB;
constexpr size_t WS_TOKINFO = 63 * MiB;
constexpr size_t WS_TOKSLOT = 63 * MiB + 512 * 1024;
constexpr size_t WS_SSMP = 1 * MiB;
constexpr size_t WS_SSMY = 64 * MiB;
constexpr size_t WMUP_LAYER = MOE_FP8 ? 56 * MiB : 0, WMDN_LAYER = MOE_FP8 ? 28 * MiB : 0;
constexpr size_t WS_WMUP = 96 * MiB;
constexpr size_t WS_WMDN = 208 * MiB;
constexpr size_t WS_PROJ = 264 * MiB;
constexpr size_t WS_MIX = 424 * MiB;
constexpr size_t WS_H = 488 * MiB;
constexpr size_t WS_HID = 264 * MiB;
constexpr size_t WS_HPERM = 264 * MiB;
constexpr size_t WS_YPERM = 264 * MiB;
constexpr size_t WS_HIDP = 396 * MiB;
constexpr size_t WS_SWIN = 12 * MiB + 256 * 1024;
constexpr size_t WS_SWOUT = 12 * MiB + 512 * 1024;
constexpr size_t WS_SLOTTOK = 13 * MiB;
constexpr size_t WS_RSM = 12 * MiB;
constexpr size_t WS_RS = 63 * MiB;
constexpr size_t WS_XRES = 640 * MiB;
constexpr size_t WS_END = 858 * MiB;
static_assert(WS_HIDP + (size_t)MOE_ROWS * DFE * 2 <= WS_END, "ws map");
static_assert(WS_HPERM + (size_t)MOE_ROWS * DM * 2 <= WS_HIDP, "ws map");

constexpr int CW_BAR = 4096;
constexpr int CW_CNT = 16384;
constexpr int CW_CUR = 16384 + 64 * 16;
constexpr int CW_AMAX = 16384 + 64 * 48;
constexpr int CW_DCQ = 16384 + 64 * 52;
constexpr int CW_LG = 16384 + 64 * 70;
constexpr int CW_CHMAXO = 65536 + 4 * 2560;
constexpr int CW_CHMAX = 65536;
constexpr int CW_CVQ = 16384 + 64 * 40;

constexpr int RING_BYTES = 131072;
constexpr int LDSCTL_OFF = RING_BYTES, MISC_OFF = LDSCTL_OFF + 320;
constexpr int LDS_BYTES = 147456;
constexpr int NWAVES = 8;

__device__ __forceinline__ float bf2f(unsigned short u) { return __uint_as_float((unsigned)u << 16); }
__device__ __forceinline__ unsigned f2bf(float f) { unsigned u = __float_as_uint(f); return (u + 0x7fffu + ((u >> 16) & 1u)) >> 16; }
__device__ __forceinline__ unsigned pk2(float lo, float hi) { typedef float f2_ __attribute__((ext_vector_type(2))); typedef __bf16 b2_ __attribute__((ext_vector_type(2))); f2_ v = {lo, hi}; b2_ b = __builtin_convertvector(v, b2_); return __builtin_bit_cast(unsigned, b); }
__device__ __forceinline__ float lo_bf(unsigned w) { return __uint_as_float(w << 16); }
__device__ __forceinline__ float hi_bf(unsigned w) { return __uint_as_float(w & 0xffff0000u); }
#define LDS_WAIT() asm volatile("s_waitcnt lgkmcnt(0)" ::: "memory")
#define VM_WAIT() asm volatile("s_waitcnt vmcnt(0)" ::: "memory")

__device__ __forceinline__ unsigned pack4_fp8(float a, float b, float c, float d) {
    a = __builtin_amdgcn_fmed3f(a, -448.f, 448.f); b = __builtin_amdgcn_fmed3f(b, -448.f, 448.f); c = __builtin_amdgcn_fmed3f(c, -448.f, 448.f); d = __builtin_amdgcn_fmed3f(d, -448.f, 448.f);
    int r = __builtin_amdgcn_cvt_pk_fp8_f32(a, b, 0, false); r = __builtin_amdgcn_cvt_pk_fp8_f32(c, d, r, true); return (unsigned)r;
}
__device__ __forceinline__ unsigned pack4_i8(float a, float b, float c, float d) {
    const int ia = (int)__builtin_amdgcn_fmed3f(rintf(a), -127.f, 127.f), ib = (int)__builtin_amdgcn_fmed3f(rintf(b), -127.f, 127.f), ic = (int)__builtin_amdgcn_fmed3f(rintf(c), -127.f, 127.f), id = (int)__builtin_amdgcn_fmed3f(rintf(d), -127.f, 127.f);
    return ((unsigned)ia & 0xffu) | (((unsigned)ib & 0xffu) << 8) | (((unsigned)ic & 0xffu) << 16) | ((unsigned)id << 24);
}
namespace pg8 {
#define PG8_LAS __attribute__((address_space(3)))
typedef unsigned short bf16_t;
typedef unsigned u32x4 __attribute__((ext_vector_type(4)));
typedef int v4i_t __attribute__((ext_vector_type(4)));
typedef int v8i_t __attribute__((ext_vector_type(8)));
constexpr int BM = 256, BK = 64, HALF = 128, HTB = HALF * BK * 2, STAGE_BYTES = 8 * HTB, NXCD = 8, WGM = 8;

__host__ __device__ __forceinline__ int lds_byte(int r, int c) { const int st = (r >> 4) * 2 + (c >> 5), rr = r & 15, cc = c & 31, ob = rr * 64 + cc * 2; return st * 1024 + (ob ^ (((ob >> 9) & 1) << 5)); }
__host__ __device__ __forceinline__ void stage_rc(int b, int& R, int& C) { const int st = b / 1024, sb = b % 1024, swz = sb ^ (((sb >> 9) & 1) << 5); R = (st >> 1) * 16 + swz / 64; C = (st & 1) * 32 + (swz % 64) / 2; }
__host__ __device__ __forceinline__ int perm32(int rho) { const int n = rho >> 4, i = rho & 15; return 8 * (i >> 2) + 4 * n + (i & 3); }

struct Unit { int pm, pn; const char* A; const char* B; };

struct Order {
    int nM, nN, nwg, G, c, rev; const char* A; const char* Bt; size_t tstep; size_t estride; const LAS int* tstart; const int* gmap = nullptr;
    __device__ __forceinline__ void init(int nM_, int nN_, int G_, int c_, const void* A_, const void* Bt_, int K, size_t estride_, const LAS int* tstart_) {
        nM = nM_; nN = nN_; nwg = nM * nN; G = G_; c = c_; rev = 0; A = (const char*)A_; Bt = (const char*)Bt_; tstep = (size_t)BM * K * 2; estride = estride_; tstart = tstart_; }
    __device__ __forceinline__ bool next(int i, Unit& u) const {
        const long L = (long)i * G + c; if (L >= nwg) return false;
        int wgid = (int)L; { const int q = nwg / NXCD, r = nwg % NXCD, xcd = wgid % NXCD, len = q + (xcd < r ? 1 : 0); int off = wgid / NXCD; if (rev) off = len - 1 - off;
          wgid = (xcd < r ? xcd * (q + 1) : r * (q + 1) + (xcd - r) * q) + off; }
        const int nig = WGM * nN, gid = wgid / nig, fm = gid * WGM, gsz = (nM - fm) < WGM ? (nM - fm) : WGM;
        u.pm = fm + ((wgid % nig) % gsz); u.pn = (wgid % nig) / gsz;
        int e = 0;
        if (tstart) {
#pragma unroll
            for (int k = 1; k < 8; ++k) e += (u.pm >= tstart[k]) ? 1 : 0;
        }
        e = __builtin_amdgcn_readfirstlane(e);
        u.A = A + (size_t)u.pm * tstep; u.B = Bt + (size_t)e * estride + (size_t)u.pn * tstep; return true;
    }
};

__device__ __forceinline__ unsigned cvt_pk_bf16(float lo, float hi) { unsigned r; asm volatile("v_cvt_pk_bf16_f32 %0, %1, %2" : "=v"(r) : "v"(lo), "v"(hi)); return r; }

struct EpiBf16 {
    static constexpr bool PERM = true;
    bf16_t* O; int ldc; float sc;
    __device__ __forceinline__ void operator()(const f32x4 (&acc)[2][2][4][2], const Unit& u, int wr, int wc, int fr, int fq) const {
        const int row0 = u.pm * BM + wr * 64 + fr; const int col0 = u.pn * BM + wc * 32 + 8 * fq;
#pragma unroll
        for (int ai = 0; ai < 2; ++ai)
#pragma unroll
            for (int m = 0; m < 4; ++m) { bf16_t* rowp = O + (size_t)(row0 + ai * HALF + m * 16) * ldc + col0;
#pragma unroll
                for (int bj = 0; bj < 2; ++bj) { const f32x4 v0 = acc[ai][bj][m][0] * sc, v1 = acc[ai][bj][m][1] * sc;
                    u32x4 w; w.x = cvt_pk_bf16(v0[0], v0[1]); w.y = cvt_pk_bf16(v0[2], v0[3]); w.z = cvt_pk_bf16(v1[0], v1[1]); w.w = cvt_pk_bf16(v1[2], v1[3]);
                    *(u32x4*)(rowp + bj * HALF) = w; } }
    }
};
__device__ __forceinline__ float epi_shx(float v, int m, int lane) { return __int_as_float(__builtin_amdgcn_ds_bpermute((lane ^ m) << 2, __float_as_int(v))); }
template <bool I8>
struct EpiProjT {
    static constexpr bool PERM = true;
    bf16_t* O; int ldc; const float* gqc; const float* gkc; const float* gqd; const float* gkd; const float* rs; const float* sw;
    __device__ __forceinline__ void operator()(const f32x4 (&acc)[2][2][4][2], const Unit& u, int wr, int wc, int fr, int fq) const {
        const int row0 = u.pm * BM + wr * 64 + fr; const int col0 = u.pn * BM + wc * 32 + 8 * fq; const int lane = fr + 16 * fq;
        const int mode = (u.pn == 4 || u.pn == 5) ? 1 : ((u.pn == 7 || u.pn == 8) ? 2 : 0);
        float g[2][8];
#pragma unroll
        for (int bj = 0; bj < 2; ++bj)
#pragma unroll
            for (int e = 0; e < 8; ++e) g[bj][e] = 1.0f;
        if (mode == 1) { const float* gp = (u.pn == 4) ? gqc : gkc;
#pragma unroll
            for (int bj = 0; bj < 2; ++bj)
#pragma unroll
                for (int e = 0; e < 8; ++e) g[bj][e] = gp[bj * 32 + 8 * fq + e]; }
        else if (mode == 2) { const float* gp = ((u.pn == 7) ? gqd : gkd) + (wc & 1) * 32 + 8 * fq;
#pragma unroll
            for (int e = 0; e < 8; ++e) { g[0][e] = gp[e]; g[1][e] = gp[e]; } }
        float swv[2][8];
        if constexpr (I8) {
#pragma unroll
            for (int bj = 0; bj < 2; ++bj)
#pragma unroll
                for (int e = 0; e < 8; ++e) swv[bj][e] = sw[col0 + bj * HALF + e]; }
#pragma unroll
        for (int ai = 0; ai < 2; ++ai)
#pragma unroll
            for (int m = 0; m < 4; ++m) { bf16_t* rowp = O + (size_t)(row0 + ai * HALF + m * 16) * ldc + col0;
                f32x4 v[2][2];
                if constexpr (I8) { const float r = rs[row0 + ai * HALF + m * 16];
#pragma unroll
                    for (int bj = 0; bj < 2; ++bj)
#pragma unroll
                        for (int n = 0; n < 2; ++n) { const v4i_t t = __builtin_bit_cast(v4i_t, acc[ai][bj][m][n]);
                            v[bj][n] = (f32x4){(float)t[0] * (r * swv[bj][4 * n]), (float)t[1] * (r * swv[bj][4 * n + 1]), (float)t[2] * (r * swv[bj][4 * n + 2]), (float)t[3] * (r * swv[bj][4 * n + 3])}; }
                } else {
#pragma unroll
                    for (int bj = 0; bj < 2; ++bj) { v[bj][0] = acc[ai][bj][m][0]; v[bj][1] = acc[ai][bj][m][1]; } }
                if (mode != 0) {
                    float s0 = 0.f, s1 = 0.f;
#pragma unroll
                    for (int n = 0; n < 2; ++n)
#pragma unroll
                        for (int j = 0; j < 4; ++j) { s0 += v[0][n][j] * v[0][n][j]; s1 += v[1][n][j] * v[1][n][j]; }
                    s0 += epi_shx(s0, 16, lane); s0 += epi_shx(s0, 32, lane); s1 += epi_shx(s1, 16, lane); s1 += epi_shx(s1, 32, lane);
                    float r0, r1;
                    if (mode == 1) { r0 = 1.0f / sqrtf((s0 + s1) * (1.0f / 64.0f) + 1e-6f); r1 = r0; }
                    else { r0 = 1.0f / sqrtf(s0 * (1.0f / 32.0f) + 1e-6f); r1 = 1.0f / sqrtf(s1 * (1.0f / 32.0f) + 1e-6f); }
#pragma unroll
                    for (int n = 0; n < 2; ++n)
#pragma unroll
                        for (int j = 0; j < 4; ++j) { v[0][n][j] *= r0 * g[0][4 * n + j]; v[1][n][j] *= r1 * g[1][4 * n + j]; }
                }
#pragma unroll
                for (int bj = 0; bj < 2; ++bj) { const f32x4 v0 = v[bj][0], v1 = v[bj][1];
                    u32x4 w; w.x = cvt_pk_bf16(v0[0], v0[1]); w.y = cvt_pk_bf16(v0[2], v0[3]); w.z = cvt_pk_bf16(v1[0], v1[1]); w.w = cvt_pk_bf16(v1[2], v1[3]);
                    *(u32x4*)(rowp + bj * HALF) = w; } }
    }
};
typedef EpiProjT<false> EpiProj; typedef EpiProjT<true> EpiProjI8;
__device__ __forceinline__ float silu_mul(float g, float u) { return g * __builtin_amdgcn_rcpf(1.0f + __builtin_amdgcn_exp2f(-1.4426950408889634f * g)) * u; }
struct EpiSwiGLU {
    static constexpr bool PERM = true;
    bf16_t* O; int ldc;
    __device__ __forceinline__ void operator()(const f32x4 (&acc)[2][2][4][2], const Unit& u, int wr, int wc, int fr, int fq) const {
        const int row0 = u.pm * BM + wr * 64 + fr; const int col0 = u.pn * HALF + wc * 32 + 8 * fq;
#pragma unroll
        for (int ai = 0; ai < 2; ++ai)
#pragma unroll
            for (int m = 0; m < 4; ++m) { bf16_t* rowp = O + (size_t)(row0 + ai * HALF + m * 16) * ldc + col0;
                const f32x4 g0 = acc[ai][0][m][0], g1 = acc[ai][0][m][1], u0 = acc[ai][1][m][0], u1 = acc[ai][1][m][1];
                u32x4 w; w.x = cvt_pk_bf16(silu_mul(g0[0], u0[0]), silu_mul(g0[1], u0[1])); w.y = cvt_pk_bf16(silu_mul(g0[2], u0[2]), silu_mul(g0[3], u0[3]));
                w.z = cvt_pk_bf16(silu_mul(g1[0], u1[0]), silu_mul(g1[1], u1[1])); w.w = cvt_pk_bf16(silu_mul(g1[2], u1[2]), silu_mul(g1[3], u1[3]));
                *(u32x4*)rowp = w; }
    }
};
struct EpiSwiGLU8 {
    static constexpr bool PERM = true;
    unsigned char* O; int ldc; float sc;
    __device__ __forceinline__ void operator()(const f32x4 (&acc)[2][2][4][2], const Unit& u, int wr, int wc, int fr, int fq) const {
        const int row0 = u.pm * BM + wr * 64 + fr; const int col0 = u.pn * HALF + wc * 32 + 8 * fq;
#pragma unroll
        for (int ai = 0; ai < 2; ++ai)
#pragma unroll
            for (int m = 0; m < 4; ++m) { unsigned char* rowp = O + (size_t)(row0 + ai * HALF + m * 16) * ldc + col0;
                const f32x4 a0 = acc[ai][0][m][0], a1 = acc[ai][0][m][1], b0 = acc[ai][1][m][0], b1 = acc[ai][1][m][1];
                const float k1 = -1.4426950408889634f * sc, k2 = 8.0f * sc * sc;
#define SG8(a_, b_) (((a_) * (b_)) * (k2 * __builtin_amdgcn_rcpf(1.0f + __builtin_amdgcn_exp2f(k1 * (a_)))))
                typedef unsigned u32x2 __attribute__((ext_vector_type(2))); u32x2 w;
                w.x = pack4_fp8(SG8(a0[0], b0[0]), SG8(a0[1], b0[1]), SG8(a0[2], b0[2]), SG8(a0[3], b0[3]));
                w.y = pack4_fp8(SG8(a1[0], b1[0]), SG8(a1[1], b1[1]), SG8(a1[2], b1[2]), SG8(a1[3], b1[3]));
#undef SG8
                *(u32x2*)rowp = w; }
    }
};
struct EpiSwiGLUI8 {
    static constexpr bool PERM = true;
    bf16_t* O; int ldc; const float* rs; float sg, su;
    __device__ __forceinline__ void operator()(const f32x4 (&acc)[2][2][4][2], const Unit& u, int wr, int wc, int fr, int fq) const {
        const int row0 = u.pm * BM + wr * 64 + fr; const int col0 = u.pn * HALF + wc * 32 + 8 * fq;
#pragma unroll
        for (int ai = 0; ai < 2; ++ai)
#pragma unroll
            for (int m = 0; m < 4; ++m) { const int row = row0 + ai * HALF + m * 16; bf16_t* rowp = O + (size_t)row * ldc + col0;
                const float r = rs[row], rg = r * sg, ru = r * su, k1 = -1.4426950408889634f * rg, k2 = rg * ru;
                const v4i_t g0 = __builtin_bit_cast(v4i_t, acc[ai][0][m][0]), g1 = __builtin_bit_cast(v4i_t, acc[ai][0][m][1]), u0 = __builtin_bit_cast(v4i_t, acc[ai][1][m][0]), u1 = __builtin_bit_cast(v4i_t, acc[ai][1][m][1]);
#define SGI(a_, b_) (((float)(a_) * (float)(b_)) * (k2 * __builtin_amdgcn_rcpf(1.0f + __builtin_amdgcn_exp2f(k1 * (float)(a_)))))
                u32x4 w; w.x = cvt_pk_bf16(SGI(g0[0], u0[0]), SGI(g0[1], u0[1])); w.y = cvt_pk_bf16(SGI(g0[2], u0[2]), SGI(g0[3], u0[3]));
                w.z = cvt_pk_bf16(SGI(g1[0], u1[0]), SGI(g1[1], u1[1])); w.w = cvt_pk_bf16(SGI(g1[2], u1[2]), SGI(g1[3], u1[3]));
#undef SGI
                *(u32x4*)rowp = w; }
    }
};
struct EpiF32Res {
    static constexpr bool PERM = false;
    const float* res; float* out; int ldc; float sc;
    __device__ __forceinline__ void operator()(const f32x4 (&acc)[2][2][4][2], const Unit& u, int wr, int wc, int fr, int fq) const {
        const int row0 = u.pm * BM + wr * 64 + fr, col0 = u.pn * BM + wc * 32 + 4 * fq;
#pragma unroll
        for (int ai = 0; ai < 2; ++ai)
#pragma unroll
            for (int m = 0; m < 4; ++m) { const size_t off = (size_t)(row0 + ai * HALF + m * 16) * ldc + col0;
                f32x4 r[2][2];
#pragma unroll
                for (int bj = 0; bj < 2; ++bj)
#pragma unroll
                    for (int n = 0; n < 2; ++n) r[bj][n] = *(const f32x4*)(res + off + bj * HALF + n * 16);
#pragma unroll
                for (int bj = 0; bj < 2; ++bj)
#pragma unroll
                    for (int n = 0; n < 2; ++n) *(f32x4*)(out + off + bj * HALF + n * 16) = r[bj][n] + acc[ai][bj][m][n] * sc; }
    }
};

template <bool I8>
struct EpiResBf16T {
    static constexpr bool PERM = true;
    const float* res32; const bf16_t* res16; bf16_t* out; int ldc; float sc; const float* sw;
    __device__ __forceinline__ f32x4 val(const f32x4& a, const float* s4) const {
        if constexpr (I8) { const v4i_t t = __builtin_bit_cast(v4i_t, a); return (f32x4){(float)t[0] * s4[0], (float)t[1] * s4[1], (float)t[2] * s4[2], (float)t[3] * s4[3]}; }
        else return a * sc; }
    __device__ __forceinline__ void operator()(const f32x4 (&acc)[2][2][4][2], const Unit& u, int wr, int wc, int fr, int fq) const {
        const int row0 = u.pm * BM + wr * 64 + fr; const int col0 = u.pn * BM + wc * 32 + 8 * fq;
        float swv[2][8];
#pragma unroll
        for (int bj = 0; bj < 2; ++bj)
#pragma unroll
            for (int e = 0; e < 8; ++e) swv[bj][e] = I8 ? sw[col0 + bj * HALF + e] : 0.f;
        if (res32) {
#pragma unroll
            for (int ai = 0; ai < 2; ++ai)
#pragma unroll
                for (int m = 0; m < 4; ++m) { const size_t off = (size_t)(row0 + ai * HALF + m * 16) * ldc + col0;
                    f32x4 r[2][2];
#pragma unroll
                    for (int bj = 0; bj < 2; ++bj) { r[bj][0] = *(const f32x4*)(res32 + off + bj * HALF); r[bj][1] = *(const f32x4*)(res32 + off + bj * HALF + 4); }
#pragma unroll
                    for (int bj = 0; bj < 2; ++bj) { const f32x4 v0 = r[bj][0] + val(acc[ai][bj][m][0], swv[bj]), v1 = r[bj][1] + val(acc[ai][bj][m][1], swv[bj] + 4);
                        u32x4 w; w.x = cvt_pk_bf16(v0[0], v0[1]); w.y = cvt_pk_bf16(v0[2], v0[3]); w.z = cvt_pk_bf16(v1[0], v1[1]); w.w = cvt_pk_bf16(v1[2], v1[3]);
                        *(u32x4*)(out + off + bj * HALF) = w; } }
        } else {
            constexpr int NH = I8 ? 1 : 2;
#pragma unroll
            for (int a0 = 0; a0 < 2; a0 += NH) {
            u32x4 q[NH][4][2];
#pragma unroll
            for (int ai = 0; ai < NH; ++ai)
#pragma unroll
                for (int m = 0; m < 4; ++m)
#pragma unroll
                    for (int bj = 0; bj < 2; ++bj) q[ai][m][bj] = *(const u32x4*)(res16 + (size_t)(row0 + (a0 + ai) * HALF + m * 16) * ldc + col0 + bj * HALF);
            asm volatile("" ::: "memory");
#pragma unroll
            for (int ai = 0; ai < NH; ++ai)
#pragma unroll
                for (int m = 0; m < 4; ++m)
#pragma unroll
                    for (int bj = 0; bj < 2; ++bj) { const u32x4 t = q[ai][m][bj];
                        const f32x4 r0 = (f32x4){__uint_as_float(t.x << 16), __uint_as_float(t.x & 0xffff0000u), __uint_as_float(t.y << 16), __uint_as_float(t.y & 0xffff0000u)};
                        const f32x4 r1 = (f32x4){__uint_as_float(t.z << 16), __uint_as_float(t.z & 0xffff0000u), __uint_as_float(t.w << 16), __uint_as_float(t.w & 0xffff0000u)};
                        const f32x4 v0 = r0 + val(acc[a0 + ai][bj][m][0], swv[bj]), v1 = r1 + val(acc[a0 + ai][bj][m][1], swv[bj] + 4);
                        u32x4 w; w.x = cvt_pk_bf16(v0[0], v0[1]); w.y = cvt_pk_bf16(v0[2], v0[3]); w.z = cvt_pk_bf16(v1[0], v1[1]); w.w = cvt_pk_bf16(v1[2], v1[3]);
                        *(u32x4*)(out + (size_t)(row0 + (a0 + ai) * HALF + m * 16) * ldc + col0 + bj * HALF) = w; }
            asm volatile("" ::: "memory");
            }
        }
    }
};
typedef EpiResBf16T<false> EpiResBf16; typedef EpiResBf16T<true> EpiResBf16I8;
template <class Epi, int MODE = 0  , bool ALIGN_EPI = true, bool GATHER = false>
__device__ __forceinline__ void gemm_phase(PG8_LAS unsigned char* lds, const int tid, const int K, const Order& S, const Epi& E) {
    const int wid = __builtin_amdgcn_readfirstlane(tid >> 6), lane = tid & 63, wr = wid >> 2, wc = wid & 3, fr = lane & 15, fq = lane >> 4;
    const int nt = K / BK;
    unsigned voffA[2], voffB[2];
#pragma unroll
    for (int i = 0; i < 2; ++i) { int R, C; stage_rc(tid * 16 + i * 8192, R, C); const int Rb = Epi::PERM ? ((R & ~31) + perm32(R & 31)) : R;
        voffA[i] = (unsigned)(R * K + C) * 2u; voffB[i] = (unsigned)(Rb * K + C) * 2u; }
    const size_t kstep = (size_t)(BK * 2);
    const size_t hstep = (size_t)HALF * K * 2;
    const unsigned ldsw = (unsigned)wid * 1024u;
    const int aoff = lds_byte(wr * 64 + fr, fq * 8), boff = lds_byte(wc * 32 + fr, fq * 8);
    unsigned baseA[2][2], baseB[2][2];
#pragma unroll
    for (int b_ = 0; b_ < 2; ++b_)
#pragma unroll
        for (int h_ = 0; h_ < 2; ++h_) { baseA[b_][h_] = (unsigned)(unsigned long long)lds + (unsigned)(((b_ * 2 + h_) * HTB) + aoff); baseB[b_][h_] = (unsigned)(unsigned long long)lds + (unsigned)(((4 + b_ * 2 + h_) * HTB) + boff);
            asm volatile("" : "+v"(baseA[b_][h_]), "+v"(baseB[b_][h_])); }
#define PG8_SA(b, h) (((b) * 2 + (h)) * HTB)
#define PG8_SB(b, h) ((4 + (b) * 2 + (h)) * HTB)
#define PG8_STAGE(bufoff, gbase, voff) do { _Pragma("unroll") for (int _i = 0; _i < 2; ++_i) \
        __builtin_amdgcn_global_load_lds((const unsigned*)((const char*)(gbase) + (voff)[_i]), (PG8_LAS unsigned*)(lds + (bufoff) + ldsw + _i * 8192), 16, 0, 0); } while (0)
    unsigned vgc[2][2] = {{0u, 0u}, {0u, 0u}}, vgn[2][2] = {{0u, 0u}, {0u, 0u}};
#define PG8_GLOAD(dst, pm_) do { _Pragma("unroll") for (int h_ = 0; h_ < 2; ++h_) _Pragma("unroll") for (int i_ = 0; i_ < 2; ++i_) { int R_, C_; stage_rc(tid * 16 + i_ * 8192, R_, C_); \
        dst[h_][i_] = (unsigned)S.gmap[(pm_) * BM + h_ * HALF + R_] * (unsigned)(K * 2) + (unsigned)C_ * 2u; } } while (0)
#define PG8_STAGE_A(bufoff, h, kb, nx) do { if constexpr (GATHER) { _Pragma("unroll") for (int _i = 0; _i < 2; ++_i) \
            __builtin_amdgcn_global_load_lds((const unsigned*)(S.A + (kb) + ((nx) ? vgn[h][_i] : vgc[h][_i])), (PG8_LAS unsigned*)(lds + (bufoff) + ldsw + _i * 8192), 16, 0, 0); } \
        else PG8_STAGE(bufoff, ((nx) ? nA : cA) + ((h) ? hstep : 0) + (kb), voffA); } while (0)
#define PG8_RD(base, off) (*(const PG8_LAS v4i_t*)((PG8_LAS unsigned char*)(base) + (off)))
#define PG8_LDA(dst, b, h) do { _Pragma("unroll") for (int m = 0; m < 4; ++m) { const v4i_t x0_ = PG8_RD(baseA[b][h], m * 2048), x1_ = PG8_RD(baseA[b][h], m * 2048 + 1024); \
        dst[m] = __builtin_shufflevector(x0_, x1_, 0, 1, 2, 3, 4, 5, 6, 7); } } while (0)
#define PG8_LDB(dst, b, h) do { _Pragma("unroll") for (int n = 0; n < 2; ++n) { const v4i_t x0_ = PG8_RD(baseB[b][h], n * 2048), x1_ = PG8_RD(baseB[b][h], n * 2048 + 1024); \
        dst[n] = __builtin_shufflevector(x0_, x1_, 0, 1, 2, 3, 4, 5, 6, 7); } } while (0)
#define PG8_LO(x) __builtin_bit_cast(bf16x8, __builtin_shufflevector(x, x, 0, 1, 2, 3))
#define PG8_HI(x) __builtin_bit_cast(bf16x8, __builtin_shufflevector(x, x, 4, 5, 6, 7))
#define PG8_MMA(ai, bj, At, Bt) do { __builtin_amdgcn_s_setprio(1); _Pragma("unroll") for (int m = 0; m < 4; ++m) _Pragma("unroll") for (int n = 0; n < 2; ++n) { \
        if constexpr (MODE == 1) { asm volatile("v_mfma_f32_16x16x128_f8f6f4 %0, %1, %2, %0" : "+v"(acc[ai][bj][m][n]) : "v"(Bt[n]), "v"(At[m])); } \
        else if constexpr (MODE == 2) { const v4i_t b0_ = __builtin_shufflevector(Bt[n], Bt[n], 0, 1, 2, 3), b1_ = __builtin_shufflevector(Bt[n], Bt[n], 4, 5, 6, 7), a0_ = __builtin_shufflevector(At[m], At[m], 0, 1, 2, 3), a1_ = __builtin_shufflevector(At[m], At[m], 4, 5, 6, 7); \
               asm volatile("v_mfma_i32_16x16x64_i8 %0, %1, %2, %0\n\tv_mfma_i32_16x16x64_i8 %0, %3, %4, %0" : "+v"(acc[ai][bj][m][n]) : "v"(b0_), "v"(a0_), "v"(b1_), "v"(a1_)); } \
        else { acc[ai][bj][m][n] = __builtin_amdgcn_mfma_f32_16x16x32_bf16(PG8_LO(Bt[n]), PG8_LO(At[m]), acc[ai][bj][m][n], 0, 0, 0); \
               acc[ai][bj][m][n] = __builtin_amdgcn_mfma_f32_16x16x32_bf16(PG8_HI(Bt[n]), PG8_HI(At[m]), acc[ai][bj][m][n], 0, 0, 0); } } \
        __builtin_amdgcn_s_setprio(0); } while (0)
#define PG8_WAIT_V(n) asm volatile("s_waitcnt vmcnt(" #n ")" ::: "memory")
#define PG8_WAIT_L(n) asm volatile("s_waitcnt lgkmcnt(" #n ")" ::: "memory")
#define PG8_BAR __builtin_amdgcn_s_barrier()
#define PG8_SCHED __builtin_amdgcn_sched_barrier(0)
    Unit cur, nxt; int ui = 0;
    if (!S.next(0, cur)) return;
    f32x4 acc[2][2][4][2];
#pragma unroll
    for (int a = 0; a < 2; ++a)
#pragma unroll
        for (int b = 0; b < 2; ++b)
#pragma unroll
            for (int m = 0; m < 4; ++m)
#pragma unroll
                for (int n = 0; n < 2; ++n) acc[a][b][m][n] = (f32x4){0.f, 0.f, 0.f, 0.f};
    v8i_t At[4], B0[2], B1[2];
    const char* cA = cur.A; const char* cB = cur.B; const char* nA = cA;
    if constexpr (GATHER) { PG8_GLOAD(vgc, cur.pm); asm volatile("s_waitcnt vmcnt(0)" ::: "memory"); }
    PG8_STAGE(PG8_SB(0, 0), cB, voffB); PG8_STAGE(PG8_SB(0, 1), cB + hstep, voffB); PG8_STAGE_A(PG8_SA(0, 0), 0, (size_t)0, false); PG8_STAGE_A(PG8_SA(0, 1), 1, (size_t)0, false);
    if (wr == 1) PG8_BAR;
    PG8_WAIT_V(2); PG8_BAR;
    PG8_STAGE(PG8_SB(1, 0), cB + kstep, voffB); PG8_STAGE_A(PG8_SA(1, 0), 0, kstep, false); PG8_STAGE(PG8_SB(1, 1), cB + hstep + kstep, voffB);
    PG8_WAIT_V(6); PG8_BAR;
    for (;;) {
        const bool has_next = S.next(ui + 1, nxt);
        nA = has_next ? nxt.A : cA; const char* nB = has_next ? nxt.B : cB;
        if constexpr (GATHER) { if (has_next && nxt.pm != cur.pm) { PG8_GLOAD(vgn, nxt.pm); asm volatile("s_waitcnt vmcnt(0)" ::: "memory"); } else { vgn[0][0] = vgc[0][0]; vgn[0][1] = vgc[0][1]; vgn[1][0] = vgc[1][0]; vgn[1][1] = vgc[1][1]; } }
        for (int t = 0; t < nt; t += 2) {
            const bool last = (t == nt - 2);
            const size_t k1 = (size_t)(t + 1) * kstep, k2 = last ? (size_t)0 : (size_t)(t + 2) * kstep, k3 = k2 + kstep;
            const char* b2 = last ? nB : cB + (size_t)(t + 2) * kstep;
            const char* b3 = b2 + kstep;
            PG8_LDB(B0, 0, 0); PG8_LDB(B1, 0, 1); PG8_SCHED; PG8_LDA(At, 0, 0); PG8_STAGE_A(PG8_SA(1, 1), 1, k1, false);
            PG8_WAIT_V(8); PG8_WAIT_L(0); PG8_BAR; PG8_MMA(0, 0, At, B0); PG8_MMA(0, 1, At, B1); PG8_BAR; PG8_SCHED;
            PG8_LDA(At, 0, 1); PG8_STAGE(PG8_SB(0, 0), b2, voffB); PG8_STAGE(PG8_SB(0, 1), b2 + hstep, voffB); PG8_STAGE_A(PG8_SA(0, 0), 0, k2, last);
            PG8_WAIT_V(8); PG8_WAIT_L(0); PG8_BAR; PG8_MMA(1, 0, At, B0); PG8_MMA(1, 1, At, B1); PG8_BAR; PG8_SCHED;
            PG8_LDB(B0, 1, 0); PG8_LDB(B1, 1, 1); PG8_SCHED; PG8_LDA(At, 1, 0); PG8_STAGE_A(PG8_SA(0, 1), 1, k2, last);
            PG8_WAIT_V(8); PG8_WAIT_L(0); PG8_BAR; PG8_MMA(0, 0, At, B0); PG8_MMA(0, 1, At, B1); PG8_BAR; PG8_SCHED;
            PG8_LDA(At, 1, 1); PG8_STAGE(PG8_SB(1, 0), b3, voffB); PG8_STAGE(PG8_SB(1, 1), b3 + hstep, voffB); PG8_STAGE_A(PG8_SA(1, 0), 0, k3, last);
            PG8_WAIT_V(8); PG8_WAIT_L(0); PG8_BAR; PG8_MMA(1, 0, At, B0); PG8_MMA(1, 1, At, B1); PG8_BAR; PG8_SCHED;
        }
        if constexpr (ALIGN_EPI) { if (wr == 0) PG8_BAR; }
        if constexpr (MODE != 0) asm volatile("s_nop 15\n\ts_nop 15" ::: "memory");
        E(acc, cur, wr, wc, fr, fq);
        if (!has_next) break;
#pragma unroll
        for (int a = 0; a < 2; ++a)
#pragma unroll
            for (int b = 0; b < 2; ++b)
#pragma unroll
                for (int m = 0; m < 4; ++m)
#pragma unroll
                    for (int n = 0; n < 2; ++n) acc[a][b][m][n] = (f32x4){0.f, 0.f, 0.f, 0.f};
        cur = nxt; cA = nA; cB = nB; ++ui;
        if constexpr (GATHER) { vgc[0][0] = vgn[0][0]; vgc[0][1] = vgn[0][1]; vgc[1][0] = vgn[1][0]; vgc[1][1] = vgn[1][1]; }
        if constexpr (ALIGN_EPI) { if (wr == 1) PG8_BAR; }
    }
    PG8_WAIT_V(0);
    if constexpr (!ALIGN_EPI) { if (wr == 0) PG8_BAR; }
    PG8_BAR;
#undef PG8_SA
#undef PG8_SB
#undef PG8_STAGE
#undef PG8_STAGE_A
#undef PG8_GLOAD
#undef PG8_LDA
#undef PG8_LDB
#undef PG8_MMA
#undef PG8_LO
#undef PG8_HI
#undef PG8_RD
#undef PG8_WAIT_V
#undef PG8_WAIT_L
#undef PG8_BAR
#undef PG8_SCHED
}
}

#define XB_TMO      128
#define XB_XCNT(j)  (256  + 64 * (j))
#define XB_XSUB(j)  (1280 + 64 * (j))
#define XB_XGEN(j)  (2304 + 64 * (j))
#define XB_TOP      3328
#define XB_TOPGEN   3392
#define XCD_BAR_WORDS 3456
#define XB_SPIN_CAP (1u << 22)

__device__ __forceinline__ unsigned xb_ld(unsigned* p)              { return __hip_atomic_load(p, __ATOMIC_RELAXED, __HIP_MEMORY_SCOPE_AGENT); }
__device__ __forceinline__ unsigned xb_add(unsigned* p, unsigned v) { return __hip_atomic_fetch_add(p, v, __ATOMIC_RELAXED, __HIP_MEMORY_SCOPE_AGENT); }
__device__ __forceinline__ unsigned xb_xcc_id() { return (unsigned)__builtin_amdgcn_s_getreg((3 << 11) | 20) & 0xFu; }
#define XB_SPIN(cond, bar) do { unsigned _sp = 0; while (cond) { __builtin_amdgcn_s_sleep(1); \
    if ((++_sp & 255u) == 0u) { if (xb_ld(&(bar)[XB_TMO])) break; if (_sp > XB_SPIN_CAP) { atomicAdd(&(bar)[XB_TMO], 1u); break; } } } } while (0)

struct XcdBarrier { unsigned* bar; unsigned x; volatile LAS unsigned* st; };

__device__ __forceinline__ XcdBarrier xcd_barrier_post(unsigned* bar, volatile LAS unsigned* st) {
    XcdBarrier b; b.bar = bar; b.x = xb_xcc_id(); b.st = st;
    if (threadIdx.x == 0) (void)xb_add(&bar[XB_XCNT(b.x)], 1u);
    return b;
}
__device__ __forceinline__ void xcd_barrier_complete(unsigned* bar, unsigned x, unsigned& nloc, unsigned& nx) {
    const unsigned G = gridDim.x * gridDim.y * gridDim.z;
    unsigned sum, cnt, mine, sp = 0u;
    for (;;) {
        sum = 0u; cnt = 0u; mine = 0u;
#pragma unroll
        for (unsigned j = 0; j < 16; ++j) { const unsigned c = xb_ld(&bar[XB_XCNT(j)]); sum += c; cnt += (c > 0u) ? 1u : 0u; mine = (j == x) ? c : mine; }
        if (sum == G) break;
        __builtin_amdgcn_s_sleep(1);
        if ((++sp & 255u) == 0u) { if (xb_ld(&bar[XB_TMO])) break; if (sp > XB_SPIN_CAP) { atomicAdd(&bar[XB_TMO], 1u); break; } }
    }
    nloc = mine > 0u ? mine : 1u; nx = cnt > 0u ? cnt : 1u;
}
__device__ __forceinline__ void xcd_barrier(LAS unsigned char* lds0_, int wave_) {
    unsigned l_ = (unsigned)(unsigned long long)lds0_; asm volatile("" : "+s"(l_)); LAS unsigned char* const ldsb = (LAS unsigned char*)l_;
    XcdBarrier b;
    { const volatile LAS unsigned* p = (const volatile LAS unsigned*)(ldsb + LDSCTL_OFF) + 2 * 30;
      const unsigned lo = (unsigned)__builtin_amdgcn_readfirstlane((int)p[0]), hi = (unsigned)__builtin_amdgcn_readfirstlane((int)p[1]);
      b.bar = (unsigned*)(GAS unsigned*)(((unsigned long long)hi << 32) | lo) + CW_BAR; }
    b.x = xb_xcc_id(); b.st = (volatile LAS unsigned*)(ldsb + MISC_OFF) + 8;
    int tid_; asm volatile("v_mbcnt_lo_u32_b32 %0, -1, 0\n\tv_mbcnt_hi_u32_b32 %0, -1, %0" : "=v"(tid_)); tid_ += 64 * wave_;
    asm volatile("s_waitcnt vmcnt(0)" ::: "memory");
    __syncthreads();
    if (tid_ == 0) {
        unsigned* bar = b.bar;
        __builtin_amdgcn_s_waitcnt(0);
        unsigned nloc = b.st[0], nx = b.st[1];
        if (nloc == 0u) { xcd_barrier_complete(bar, b.x, nloc, nx); b.st[0] = nloc; b.st[1] = nx; }
        const unsigned old = xb_add(&bar[XB_XSUB(b.x)], 1u);
        const unsigned gen = old / nloc;
        if (old + 1u == (gen + 1u) * nloc) {
            __builtin_amdgcn_fence(__ATOMIC_RELEASE, "agent");
            asm volatile("s_waitcnt vmcnt(0)" ::: "memory");
            const unsigned og = xb_add(&bar[XB_TOP], 1u);
            const unsigned tg = og / nx;
            if (og + 1u == (tg + 1u) * nx) xb_add(&bar[XB_TOPGEN], 1u);
            else XB_SPIN(xb_ld(&bar[XB_TOPGEN]) == tg, bar);
            __builtin_amdgcn_fence(__ATOMIC_ACQUIRE, "agent");
            xb_add(&bar[XB_XGEN(b.x)], 1u);
            asm volatile("s_waitcnt vmcnt(0)" ::: "memory");
        } else {
            XB_SPIN(xb_ld(&bar[XB_XGEN(b.x)]) == gen, bar);
            __builtin_amdgcn_fence(__ATOMIC_ACQUIRE, "agent");
            asm volatile("s_waitcnt vmcnt(0)" ::: "memory");
        }
    }
    __syncthreads();
}

#define XB_LSUB(j)  (3584 + 64 * (j))
#define XB_LGEN(j)  (4608 + 64 * (j))
__device__ __forceinline__ void xcd_local_barrier(LAS unsigned char* lds0_, int wave_) {
    unsigned l_ = (unsigned)(unsigned long long)lds0_; asm volatile("" : "+s"(l_)); LAS unsigned char* const ldsb = (LAS unsigned char*)l_;
    unsigned* bar;
    { const volatile LAS unsigned* p = (const volatile LAS unsigned*)(ldsb + LDSCTL_OFF) + 2 * 30;
      const unsigned lo = (unsigned)__builtin_amdgcn_readfirstlane((int)p[0]), hi = (unsigned)__builtin_amdgcn_readfirstlane((int)p[1]);
      bar = (unsigned*)(GAS unsigned*)(((unsigned long long)hi << 32) | lo) + CW_BAR; }
    const unsigned x = xb_xcc_id(); volatile LAS unsigned* st = (volatile LAS unsigned*)(ldsb + MISC_OFF) + 8;
    int tid_; asm volatile("v_mbcnt_lo_u32_b32 %0, -1, 0\n\tv_mbcnt_hi_u32_b32 %0, -1, %0" : "=v"(tid_)); tid_ += 64 * wave_;
    asm volatile("s_waitcnt vmcnt(0)" ::: "memory");
    __syncthreads();
    if (tid_ == 0) {
        __builtin_amdgcn_s_waitcnt(0);
        const unsigned nloc = st[0];
        const unsigned old = xb_add(&bar[XB_LSUB(x)], 1u);
        const unsigned gen = old / nloc;
        if (old + 1u == (gen + 1u) * nloc) xb_add(&bar[XB_LGEN(x)], 1u);
        else XB_SPIN(xb_ld(&bar[XB_LGEN(x)]) == gen, bar);
        __builtin_amdgcn_fence(__ATOMIC_ACQUIRE, "agent");
        asm volatile("s_waitcnt vmcnt(0)" ::: "memory");
    }
    __syncthreads();
}

struct Frame {
    LAS unsigned char* lds;
    volatile LAS unsigned* MISC;
    int tid, lane, wave, vcu, G, vz, bx, wave0;
    struct InTab { LAS unsigned char* lds;
        __device__ __forceinline__ const float* operator[](int k) const {
            const volatile LAS unsigned* p = (const volatile LAS unsigned*)(lds + LDSCTL_OFF) + 2 * k;
            const unsigned lo = (unsigned)__builtin_amdgcn_readfirstlane((int)p[0]), hi = (unsigned)__builtin_amdgcn_readfirstlane((int)p[1]);
            const GAS float* qg = (const GAS float*)(((unsigned long long)hi << 32) | lo);
            const float* q = (const float*)qg;
            return q; } } in;
    __device__ __forceinline__ float* out() const { return (float*)in[29]; }
    __device__ __forceinline__ unsigned char* ws() const { return (unsigned char*)in[30]; }
    __device__ __forceinline__ gu32* ctl() const { return (gu32*)in[30]; }
};

__device__ __forceinline__ void refresh(Frame& F, LAS unsigned char* lds0) {
    int wv = F.wave0; asm volatile("" : "+s"(wv));
    int t; asm volatile("v_mbcnt_lo_u32_b32 %0, -1, 0\n\tv_mbcnt_hi_u32_b32 %0, -1, %0" : "=v"(t));
    F.lane = t; F.wave = wv; F.tid = wv * 64 + t;
    int bx = blockIdx.x, G = gridDim.x; asm volatile("" : "+s"(bx), "+s"(G)); F.bx = bx; F.G = G; F.vcu = (G % 8 == 0) ? (bx % 8) * (G / 8) + bx / 8 : bx;
    unsigned l = (unsigned)(unsigned long long)lds0; asm volatile("" : "+s"(l)); F.lds = (LAS unsigned char*)l;
    F.MISC = (volatile LAS unsigned*)(F.lds + MISC_OFF); F.in.lds = F.lds;
    int z; asm volatile("v_mov_b32 %0, 0" : "=v"(z)); F.vz = z;
}
__device__ __forceinline__ float shx(float v, int m, int lane) { return __int_as_float(__builtin_amdgcn_ds_bpermute((lane ^ m) << 2, __float_as_int(v))); }
__device__ __forceinline__ float wave_sum(float v, int lane) {
#pragma unroll
    for (int o = 1; o < 64; o <<= 1) v += shx(v, o, lane);
    return v;
}

template <int CM  >
__device__ __forceinline__ void transpose_item(const float* W, int K, int N, void* WTv, int mode, float scale, LAS float* scr, int item, int lane, const float* kfac = nullptr, float kf_hi = 1.0f  ) {
    constexpr int KS = CM ? 128 : 64;
    const int nblk = N / 64, kb = item / nblk, nb = item % nblk, k0 = KS * kb, n0 = 64 * nb;
    int drow = (mode == 0 || mode == 3) ? n0 + lane : ((n0 >> 7) * 256 + (n0 & 127) + (mode == 2 ? 128 : 0)) + lane;
    if (mode == 3 && n0 >= C_QCH && n0 < C_VCH) { const int n = n0 + lane, d = n & 63, h = (n >> 6) & 3; drow = (n & ~255) + (d >> 5) * 128 + 32 * h + (d & 31); }
    const int kr = lane >> 4, n4 = (lane & 15) * 4;
    f32x4 vset[2][8];
#pragma unroll
    for (int i = 0; i < 8; ++i) vset[0][i] = __builtin_nontemporal_load((const f32x4*)(W + (size_t)(k0 + 4 * i + kr) * N + n0 + n4));
#pragma unroll
    for (int sub = 0; sub < KS / 32; ++sub) {
        if (sub + 1 < KS / 32) {
#pragma unroll
            for (int i = 0; i < 8; ++i) vset[(sub + 1) & 1][i] = __builtin_nontemporal_load((const f32x4*)(W + (size_t)(k0 + (sub + 1) * 32 + 4 * i + kr) * N + n0 + n4));
        }
#pragma unroll
        for (int i = 0; i < 8; ++i) { LAS float* d = scr + (4 * i + kr) * 65 + n4; const f32x4 t = vset[sub & 1][i]; d[0] = t.x; d[1] = t.y; d[2] = t.z; d[3] = t.w; }
        LDS_WAIT(); asm volatile("" ::: "memory");
        float x[32];
#pragma unroll
        for (int k = 0; k < 32; ++k) x[k] = scr[k * 65 + lane] * scale;
        if (kfac) { const float* kp = kfac + k0 + sub * 32; const float hf = (k0 + sub * 32 >= 768) ? kf_hi : 1.0f;
#pragma unroll
            for (int k = 0; k < 32; ++k) x[k] *= kp[k] * hf; }
        if constexpr (CM == 2) {
            unsigned char* dst = (unsigned char*)WTv + (size_t)drow * K + k0 + sub * 32;
#pragma unroll
            for (int q = 0; q < 2; ++q) { v4u o; o.x = pack4_i8(x[16 * q], x[16 * q + 1], x[16 * q + 2], x[16 * q + 3]); o.y = pack4_i8(x[16 * q + 4], x[16 * q + 5], x[16 * q + 6], x[16 * q + 7]);
                o.z = pack4_i8(x[16 * q + 8], x[16 * q + 9], x[16 * q + 10], x[16 * q + 11]); o.w = pack4_i8(x[16 * q + 12], x[16 * q + 13], x[16 * q + 14], x[16 * q + 15]); *(v4u*)(dst + 16 * q) = o; }
        } else if constexpr (CM == 1) {
            unsigned char* dst = (unsigned char*)WTv + (size_t)drow * K + k0 + sub * 32;
#pragma unroll
            for (int q = 0; q < 2; ++q) { v4u o; o.x = pack4_fp8(x[16 * q], x[16 * q + 1], x[16 * q + 2], x[16 * q + 3]); o.y = pack4_fp8(x[16 * q + 4], x[16 * q + 5], x[16 * q + 6], x[16 * q + 7]);
                o.z = pack4_fp8(x[16 * q + 8], x[16 * q + 9], x[16 * q + 10], x[16 * q + 11]); o.w = pack4_fp8(x[16 * q + 12], x[16 * q + 13], x[16 * q + 14], x[16 * q + 15]); *(v4u*)(dst + 16 * q) = o; }
        } else {
            bf16* dst = (bf16*)WTv + (size_t)drow * K + k0 + sub * 32;
#pragma unroll
            for (int q = 0; q < 4; ++q) { v4u o; o.x = pk2(x[8 * q], x[8 * q + 1]); o.y = pk2(x[8 * q + 2], x[8 * q + 3]); o.z = pk2(x[8 * q + 4], x[8 * q + 5]); o.w = pk2(x[8 * q + 6], x[8 * q + 7]); *(v4u*)(dst + 8 * q) = o; }
        }
        LDS_WAIT(); asm volatile("" ::: "memory");
    }
}

__device__ __forceinline__ float wave_max(float v, int lane) {
#pragma unroll
    for (int o = 1; o < 64; o <<= 1) v = fmaxf(v, shx(v, o, lane));
    return v;
}
__device__ __forceinline__ void dense_amax(Frame& F) {
    const int gw = F.vcu * NWAVES + F.wave, NGW = F.G * NWAVES;
    constexpr int NV = DM * DFF / 256;
#pragma unroll
    for (int t = 0; t < 4; ++t) {
        const float* W = ((t & 1) ? F.in[23] : F.in[22]) + (size_t)(t >> 1) * DM * DFF;
        float m = 0.f;
        for (int idx = gw; idx < NV; idx += NGW) { const f32x4 v = __builtin_nontemporal_load((const f32x4*)W + (size_t)idx * 64 + F.lane); m = fmaxf(m, fmaxf(fmaxf(fabsf(v.x), fabsf(v.y)), fmaxf(fabsf(v.z), fabsf(v.w)))); }
        m = wave_max(m, F.lane);
        if (F.lane == 0) __hip_atomic_fetch_max((unsigned*)(F.ctl() + CW_AMAX + 64 * t), __float_as_uint(m), __ATOMIC_RELAXED, __HIP_MEMORY_SCOPE_AGENT);
    }
}
__device__ __forceinline__ void win_amax(Frame& F) {
    const int gw = F.vcu * NWAVES + F.wave, NGW = F.G * NWAVES;
    constexpr int NCB = INC / 256, NKC = DM / 32, NIT = 4 * NCB * NKC;
    for (int it = gw; it < NIT; it += NGW) { const int l = it / (NCB * NKC), r = it % (NCB * NKC), cb = r % NCB, kc = r / NCB;
        const float* W = F.in[2] + (size_t)l * DM * INC + (size_t)(kc * 32) * INC + cb * 256 + 4 * F.lane;
        f32x4 m = (f32x4){0.f, 0.f, 0.f, 0.f};
#pragma unroll 8
        for (int k = 0; k < 32; ++k) { const f32x4 v = *(const f32x4*)(W + (size_t)k * INC); m.x = fmaxf(m.x, fabsf(v.x)); m.y = fmaxf(m.y, fabsf(v.y)); m.z = fmaxf(m.z, fabsf(v.z)); m.w = fmaxf(m.w, fabsf(v.w)); }
        unsigned* dst = (unsigned*)(F.ctl() + CW_CHMAX + l * INC + cb * 256 + 4 * F.lane);
        __hip_atomic_fetch_max(dst, __float_as_uint(m.x), __ATOMIC_RELAXED, __HIP_MEMORY_SCOPE_AGENT); __hip_atomic_fetch_max(dst + 1, __float_as_uint(m.y), __ATOMIC_RELAXED, __HIP_MEMORY_SCOPE_AGENT);
        __hip_atomic_fetch_max(dst + 2, __float_as_uint(m.z), __ATOMIC_RELAXED, __HIP_MEMORY_SCOPE_AGENT); __hip_atomic_fetch_max(dst + 3, __float_as_uint(m.w), __ATOMIC_RELAXED, __HIP_MEMORY_SCOPE_AGENT);
    }
}
__device__ __forceinline__ void win_convert(Frame& F) {
    LAS float* scr = (LAS float*)(F.lds + F.wave * 16384);
    const int gw = F.vcu * NWAVES + F.wave, NGW = F.G * NWAVES;
    constexpr int I_IN8 = (DM / 128) * (INC / 64);
    for (int it = gw; it < 4 * I_IN8; it += NGW) { const int l = it / I_IN8, item = it % I_IN8, n = 64 * (item % (INC / 64)) + F.lane;
        const float cm = __uint_as_float(__hip_atomic_load((unsigned*)(F.ctl() + CW_CHMAX + l * INC + n), __ATOMIC_RELAXED, __HIP_MEMORY_SCOPE_AGENT));
        if (item < INC / 64) { int drow = n; if (n >= C_QCH && n < C_VCH) { const int d = n & 63, h = (n >> 6) & 3; drow = (n & ~255) + (d >> 5) * 128 + 32 * h + (d & 31); }
            ((float*)(F.ws() + WS_SWIN))[l * INC + drow] = cm * (1.0f / 127.0f); }
        transpose_item<2>(F.in[2] + (size_t)l * DM * INC, DM, INC, (unsigned char*)(F.ws() + WS_WIN) + (size_t)l * INC * DM, 3, cm > 0.f ? 127.0f / cm : 0.f, scr, item, F.lane); }
}
__device__ __forceinline__ float df_head_scale(int l) { return 1.0f - (0.8f - 0.6f * expf(-0.3f * (float)l)); }
__device__ __forceinline__ void wout_amax(Frame& F) {
    const int gw = F.vcu * NWAVES + F.wave, NGW = F.G * NWAVES;
    constexpr int NCB = DM / 256, NKC = DM / 32, NIT = 4 * NCB * NKC;
    for (int it = gw; it < NIT; it += NGW) { const int l = it / (NCB * NKC), r = it % (NCB * NKC), cb = r % NCB, kc = r / NCB;
        const float* W = F.in[20] + (size_t)l * DM * DM + (size_t)(kc * 32) * DM + cb * 256 + 4 * F.lane;
        const float* gp = F.in[19] + l * DM + kc * 32; const float hf = (kc * 32 >= 768) ? df_head_scale(l) : 1.0f;
        f32x4 m = (f32x4){0.f, 0.f, 0.f, 0.f};
#pragma unroll 8
        for (int k = 0; k < 32; ++k) { const f32x4 v = *(const f32x4*)(W + (size_t)k * DM); const float gk = fabsf(gp[k] * hf);
            m.x = fmaxf(m.x, fabsf(v.x) * gk); m.y = fmaxf(m.y, fabsf(v.y) * gk); m.z = fmaxf(m.z, fabsf(v.z) * gk); m.w = fmaxf(m.w, fabsf(v.w) * gk); }
        unsigned* dst = (unsigned*)(F.ctl() + CW_CHMAXO + l * DM + cb * 256 + 4 * F.lane);
        __hip_atomic_fetch_max(dst, __float_as_uint(m.x), __ATOMIC_RELAXED, __HIP_MEMORY_SCOPE_AGENT); __hip_atomic_fetch_max(dst + 1, __float_as_uint(m.y), __ATOMIC_RELAXED, __HIP_MEMORY_SCOPE_AGENT);
        __hip_atomic_fetch_max(dst + 2, __float_as_uint(m.z), __ATOMIC_RELAXED, __HIP_MEMORY_SCOPE_AGENT); __hip_atomic_fetch_max(dst + 3, __float_as_uint(m.w), __ATOMIC_RELAXED, __HIP_MEMORY_SCOPE_AGENT);
    }
}
__device__ __forceinline__ void wout_convert(Frame& F) {
    LAS float* scr = (LAS float*)(F.lds + F.wave * 16384);
    const int gw = F.vcu * NWAVES + F.wave, NGW = F.G * NWAVES;
    constexpr int I_OUT8 = (DM / 128) * (DM / 64);
    for (int it = gw; it < 4 * I_OUT8; it += NGW) { const int l = it / I_OUT8, item = it % I_OUT8, n = 64 * (item % (DM / 64)) + F.lane;
        const float cm = __uint_as_float(__hip_atomic_load((unsigned*)(F.ctl() + CW_CHMAXO + l * DM + n), __ATOMIC_RELAXED, __HIP_MEMORY_SCOPE_AGENT));
        if (item < DM / 64) ((float*)(F.ws() + WS_SWOUT))[l * DM + n] = cm * (1.0f / 127.0f) * (8.0f / 127.0f);
        transpose_item<2>(F.in[20] + (size_t)l * DM * DM, DM, DM, (unsigned char*)(F.ws() + WS_WOUT) + (size_t)l * DM * DM, 0, cm > 0.f ? 127.0f / cm : 0.f, scr, item, F.lane, F.in[19] + l * DM, df_head_scale(l)); }
}
__device__ __forceinline__ void dense_up_convert(Frame& F) {
    LAS float* scr = (LAS float*)(F.lds + F.wave * 16384);
    constexpr int I_FU = (DM / 128) * (DFF / 64);
    unsigned* head = (unsigned*)(F.ctl() + CW_DCQ);
    for (;;) {
        unsigned id = 0u;
        if (F.lane == 0) id = __hip_atomic_fetch_add(head, 1u, __ATOMIC_RELAXED, __HIP_MEMORY_SCOPE_AGENT);
        id = (unsigned)__builtin_amdgcn_readfirstlane((int)id);
        if (id >= (unsigned)(4 * I_FU)) break;
        const int q = (int)id / I_FU, i = q >> 1, w3 = q & 1;
        const float amax = __uint_as_float(__hip_atomic_load((unsigned*)(F.ctl() + CW_AMAX + 64 * q), __ATOMIC_RELAXED, __HIP_MEMORY_SCOPE_AGENT));
        transpose_item<2>((w3 ? F.in[23] : F.in[22]) + (size_t)i * DM * DFF, DM, DFF, (unsigned char*)(F.ws() + WS_WFUP) + (size_t)i * 2 * DFF * DM, w3 ? 2 : 1, amax > 0.f ? 127.0f / amax : 0.f, scr, (int)id % I_FU, F.lane);
    }
}
__device__ __forceinline__ void prologue_convert(Frame& F) {
    LAS float* scr = (LAS float*)(F.lds + F.wave * 16384);
    const int gw = F.vcu * NWAVES + F.wave, NGW = F.G * NWAVES;
    constexpr int KSF = DENSE_FP8 ? 128 : 64;
    constexpr int I_IN = (DM / 64) * (INC / 64), I_OUT = (DM / 64) * (DM / 64), I_FU = (DM / KSF) * (DFF / 64), I_FD = (DFF / KSF) * (DM / 64), I_GL = (256 / 64) * (256 / 64);
    constexpr int NITEMS = 4 * I_IN + 4 * I_OUT + 4 * I_FU + 2 * I_FD + 4 * I_GL;
    bf16* WIN = (bf16*)(F.ws() + WS_WIN); bf16* WOUT = (bf16*)(F.ws() + WS_WOUT); bf16* WFUP = (bf16*)(F.ws() + WS_WFUP); bf16* WFDN = (bf16*)(F.ws() + WS_WFDN);
    for (int it = gw; it < NITEMS; it += NGW) {
        int r = it;
#if WIN_I8
        if (r < 4 * I_IN) { continue; } r -= 4 * I_IN;
#else
        if (r < 4 * I_IN) { const int l = r / I_IN; transpose_item<0>(F.in[2] + (size_t)l * DM * INC, DM, INC, WIN + (size_t)l * INC * DM, 3, 1.0f, scr, r % I_IN, F.lane); continue; } r -= 4 * I_IN;
#endif
#if WOUT_I8
        if (r < 4 * I_OUT) { continue; } r -= 4 * I_OUT;
#else
        if (r < 4 * I_OUT) { const int l = r / I_OUT; transpose_item<0>(F.in[20] + (size_t)l * DM * DM, DM, DM, WOUT + (size_t)l * DM * DM, 0, 1.0f, scr, r % I_OUT, F.lane); continue; } r -= 4 * I_OUT;
#endif
#if DENSE_UP_I8
        if (r < 4 * I_FU) { continue; } r -= 4 * I_FU;
        if (r < 2 * I_FD) { const int i = r / I_FD; transpose_item<0>(F.in[24] + (size_t)i * DFF * DM, DFF, DM, WFDN + (size_t)i * DM * DFF, 0, 1.0f, scr, r % I_FD, F.lane); continue; } r -= 2 * I_FD;
#elif DENSE_FP8
        if (r < 4 * I_FU) { const int q = r / I_FU, i = q >> 1, w3 = q & 1; transpose_item<1>((w3 ? F.in[23] : F.in[22]) + (size_t)i * DM * DFF, DM, DFF, (unsigned char*)WFUP + (size_t)i * 2 * DFF * DM, w3 ? 2 : 1, WGT8, scr, r % I_FU, F.lane); continue; } r -= 4 * I_FU;
        if (r < 2 * I_FD) { const int i = r / I_FD; transpose_item<1>(F.in[24] + (size_t)i * DFF * DM, DFF, DM, (unsigned char*)WFDN + (size_t)i * DM * DFF, 0, WGT8, scr, r % I_FD, F.lane); continue; } r -= 2 * I_FD;
#else
        if (r < 4 * I_FU) { const int q = r / I_FU, i = q >> 1, w3 = q & 1; transpose_item<0>((w3 ? F.in[23] : F.in[22]) + (size_t)i * DM * DFF, DM, DFF, WFUP + (size_t)i * 2 * DFF * DM, w3 ? 2 : 1, 1.0f, scr, r % I_FU, F.lane); continue; } r -= 4 * I_FU;
        if (r < 2 * I_FD) { const int i = r / I_FD; transpose_item<0>(F.in[24] + (size_t)i * DFF * DM, DFF, DM, WFDN + (size_t)i * DM * DFF, 0, 1.0f, scr, r % I_FD, F.lane); continue; } r -= 2 * I_FD;
#endif
        { const int l = r / I_GL; transpose_item<0>(F.in[11] + (size_t)l * 65536, 256, 256, (bf16*)(F.ws() + (1 * MiB + 65536)) + (size_t)l * 65536, 0, 1.0f, scr, r % I_GL, F.lane); }
    }
}
__device__ __forceinline__ void moe_convert_half(Frame& F, int mi, int half, int maxitems = 0x7fffffff) {
    LAS float* scr = (LAS float*)(F.lds + F.wave * 16384);
    constexpr int KSF = MOE_FP8 ? 128 : 64;
    constexpr int I_MU = (DM / KSF) * (DFE / 64), I_MD = (DFE / KSF) * (DM / 64);
    constexpr int NITEMS = 16 * I_MU + 8 * I_MD, NHALF = NITEMS / 2;
    bf16* WMUP = (bf16*)(F.ws() + WS_WMUP + (size_t)mi * WMUP_LAYER); bf16* WMDN = (bf16*)(F.ws() + WS_WMDN + (size_t)mi * WMDN_LAYER);
    unsigned* head = (unsigned*)(F.ctl() + CW_CVQ + 64 * (mi * 2 + half));
    for (int taken = 0; taken < maxitems; ++taken) {
        unsigned id = 0u;
        if (F.lane == 0) id = __hip_atomic_fetch_add(head, 1u, __ATOMIC_RELAXED, __HIP_MEMORY_SCOPE_AGENT);
        id = (unsigned)__builtin_amdgcn_readfirstlane((int)id);
        if (id >= (unsigned)NHALF) break;
        int r = (int)id + half * NHALF;
        if (r < 16 * I_MU) { const int q = r / I_MU, e = q >> 1, w3 = q & 1;
#if MOE_FP8
            transpose_item<1>((w3 ? F.in[27] : F.in[26]) + ((size_t)mi * NE + e) * DM * DFE, DM, DFE, (unsigned char*)WMUP + (size_t)e * 2 * DFE * DM, w3 ? 2 : 1, WGT8, scr, r % I_MU, F.lane); continue; } r -= 16 * I_MU;
        { const int e = r / I_MD; transpose_item<1>(F.in[28] + ((size_t)mi * NE + e) * DFE * DM, DFE, DM, (unsigned char*)WMDN + (size_t)e * DM * DFE, 0, WGT8, scr, r % I_MD, F.lane); }
#else
            transpose_item<0>((w3 ? F.in[27] : F.in[26]) + ((size_t)mi * NE + e) * DM * DFE, DM, DFE, WMUP + (size_t)e * 2 * DFE * DM, w3 ? 2 : 1, 1.0f, scr, r % I_MU, F.lane); continue; } r -= 16 * I_MU;
        { const int e = r / I_MD; transpose_item<0>(F.in[28] + ((size_t)mi * NE + e) * DFE * DM, DFE, DM, WMDN + (size_t)e * DM * DFE, 0, 1.0f, scr, r % I_MD, F.lane); }
#endif
    }
}

__device__ __forceinline__ void norm_phase(Frame& F, const float* xsrc, bool combine, const float* gain, bool route, const float* wr_, int mi, bool norm, int omode  , size_t rs_off = WS_RS) {
    bf16* XR = (bf16*)(F.ws() + WS_XRES);
    const int gw = F.vcu * NWAVES + F.wave, NGW = F.G * NWAVES;
    bf16* H = (bf16*)(F.ws() + ((route && MOE_FP8) ? WS_HPERM : WS_H)); const bf16* YP = (const bf16*)(F.ws() + WS_YPERM);
    const int4* TS = (const int4*)(F.ws() + WS_TOKSLOT); int4* TI = (int4*)(F.ws() + WS_TOKINFO);
    if (route) { if (F.tid < 8) F.MISC[16 + F.tid] = 0u; __syncthreads(); }
    f32x4 g[4];
    if (norm) {
#pragma unroll
        for (int j = 0; j < 4; ++j) g[j] = *(const f32x4*)(gain + 4 * F.lane + 256 * j);
    }
#define NP_LOAD(m_, R32, R16) do { if (xsrc) { const f32x4* xr_ = (const f32x4*)(xsrc + (size_t)(m_) * DM) + F.lane; _Pragma("unroll") for (int j = 0; j < 4; ++j) R32[j] = xr_[64 * j]; } \
                                   else { const v2u* xr_ = (const v2u*)(XR + (size_t)(m_) * DM) + F.lane; _Pragma("unroll") for (int j = 0; j < 4; ++j) R16[j] = xr_[64 * j]; } } while (0)
    f32x4 c32[4], n32[4]; v2u c16[4], n16[4];
#pragma unroll
    for (int j = 0; j < 4; ++j) { c32[j] = (f32x4){0.f, 0.f, 0.f, 0.f}; n32[j] = c32[j]; c16[j] = (v2u){0u, 0u}; n16[j] = c16[j]; }
    const bool xrows = (F.G == 256);
#define NP_ROW(i_) (xrows ? ((((i_) & 2047) >> 8) * 4096 + ((i_) & 255) + 256 * ((i_) >> 11)) : (i_))
    if (gw < NTOK) NP_LOAD(NP_ROW(gw), c32, c16);
    for (int mi_ = gw; mi_ < NTOK; mi_ += NGW) {
        const int m = NP_ROW(mi_);
        if (mi_ + NGW < NTOK) NP_LOAD(NP_ROW(mi_ + NGW), n32, n16);
        f32x4 v[4];
        if (xsrc) {
#pragma unroll
            for (int j = 0; j < 4; ++j) v[j] = c32[j];
        } else {
#pragma unroll
            for (int j = 0; j < 4; ++j) v[j] = (f32x4){lo_bf(c16[j].x), hi_bf(c16[j].x), lo_bf(c16[j].y), hi_bf(c16[j].y)}; }
#pragma unroll
        for (int j = 0; j < 4; ++j) { c32[j] = n32[j]; c16[j] = n16[j]; }
        if (combine) {
            const int4 ts = TS[m + F.vz]; const float g0 = __int_as_float(ts.z), g1 = __int_as_float(ts.w);
            const v2u* y0 = (const v2u*)(YP + (size_t)ts.x * DM) + F.lane; const v2u* y1 = (const v2u*)(YP + (size_t)ts.y * DM) + F.lane;
#pragma unroll
            for (int j = 0; j < 4; ++j) { const v2u a = y0[64 * j], b = y1[64 * j];
                v[j].x += g0 * lo_bf(a.x) + g1 * lo_bf(b.x); v[j].y += g0 * hi_bf(a.x) + g1 * hi_bf(b.x);
                v[j].z += g0 * lo_bf(a.y) + g1 * lo_bf(b.y); v[j].w += g0 * hi_bf(a.y) + g1 * hi_bf(b.y); }
            if (norm) { v2u* xo = (v2u*)(XR + (size_t)m * DM) + F.lane;
#pragma unroll
                for (int j = 0; j < 4; ++j) { v2u o; o.x = pk2(v[j].x, v[j].y); o.y = pk2(v[j].z, v[j].w); xo[64 * j] = o; }
            } else { f32x4* xo = (f32x4*)(F.out() + (size_t)m * DM) + F.lane;
#pragma unroll
                for (int j = 0; j < 4; ++j) xo[64 * j] = v[j]; }
        }
        if (!norm) continue;
        float s2 = 0.f;
#pragma unroll
        for (int j = 0; j < 4; ++j) s2 += (v[j].x * v[j].x + v[j].y * v[j].y) + (v[j].z * v[j].z + v[j].w * v[j].w);
        const float rs = 1.0f / sqrtf(wave_sum(s2, F.lane) * (1.0f / DM) + EPS);
#pragma unroll
        for (int j = 0; j < 4; ++j) v[j] = v[j] * rs * g[j];
        if (omode == 2) {
            float am = 0.f;
#pragma unroll
            for (int j = 0; j < 4; ++j) am = fmaxf(am, fmaxf(fmaxf(fabsf(v[j].x), fabsf(v[j].y)), fmaxf(fabsf(v[j].z), fabsf(v[j].w))));
            am = wave_max(am, F.lane);
            const float qs = am > 0.f ? 127.0f / am : 0.f;
            unsigned* o4 = (unsigned*)((unsigned char*)H + (size_t)m * DM) + F.lane;
#pragma unroll
            for (int j = 0; j < 4; ++j) o4[64 * j] = pack4_i8(v[j].x * qs, v[j].y * qs, v[j].z * qs, v[j].w * qs);
            if (F.lane == 0) ((float*)(F.ws() + rs_off))[m] = am * (1.0f / 127.0f);
        } else if (omode == 1) { unsigned* o4 = (unsigned*)((unsigned char*)H + (size_t)m * DM) + F.lane;
#pragma unroll
            for (int j = 0; j < 4; ++j) o4[64 * j] = pack4_fp8(v[j].x * ACT8, v[j].y * ACT8, v[j].z * ACT8, v[j].w * ACT8);
        } else { unsigned long long* o8 = (unsigned long long*)(H + (size_t)m * DM) + F.lane;
#pragma unroll
            for (int j = 0; j < 4; ++j) o8[64 * j] = (unsigned long long)pk2(v[j].x, v[j].y) | ((unsigned long long)pk2(v[j].z, v[j].w) << 32); }
        if (route) {
            float lg[8];
#pragma unroll
            for (int e = 0; e < 8; ++e) lg[e] = 0.f;
#pragma unroll
            for (int j = 0; j < 4; ++j) {
#pragma unroll
                for (int c = 0; c < 4; ++c) { const int k = 4 * F.lane + 256 * j + c; const f32x4 w0 = *(const f32x4*)(wr_ + (size_t)k * 8), w1 = *(const f32x4*)(wr_ + (size_t)k * 8 + 4); const float xv = v[j][c];
                    lg[0] += xv * w0.x; lg[1] += xv * w0.y; lg[2] += xv * w0.z; lg[3] += xv * w0.w; lg[4] += xv * w1.x; lg[5] += xv * w1.y; lg[6] += xv * w1.z; lg[7] += xv * w1.w; }
            }
#pragma unroll
            for (int e = 0; e < 8; ++e) lg[e] = wave_sum(lg[e], F.lane);
            int e0 = 0; float b0 = lg[0];
#pragma unroll
            for (int e = 1; e < 8; ++e) if (lg[e] > b0) { b0 = lg[e]; e0 = e; }
            int e1 = -1; float b1 = -3.0e38f;
#pragma unroll
            for (int e = 0; e < 8; ++e) if (e != e0 && lg[e] > b1) { b1 = lg[e]; e1 = e; }
            const float p1 = __expf(b1 - b0); const float g0 = 1.0f / (1.0f + p1), g1 = p1 / (1.0f + p1);
            if (F.lane == 0) { TI[m] = make_int4(e0, e1, __float_as_int(g0), __float_as_int(g1));
                __hip_atomic_fetch_add((LAS unsigned*)(F.lds + MISC_OFF) + 16 + e0, 1u, __ATOMIC_RELAXED, __HIP_MEMORY_SCOPE_WORKGROUP); __hip_atomic_fetch_add((LAS unsigned*)(F.lds + MISC_OFF) + 16 + e1, 1u, __ATOMIC_RELAXED, __HIP_MEMORY_SCOPE_WORKGROUP); }
        }
    }
#undef NP_LOAD
    if (route) { __syncthreads(); if (F.tid < 8) { const unsigned c = F.MISC[16 + F.tid]; if (c) __hip_atomic_fetch_add((unsigned*)(F.ctl() + CW_CNT + 64 * (mi * 8 + F.tid)), c, __ATOMIC_RELAXED, __HIP_MEMORY_SCOPE_AGENT); } }
}

__device__ __forceinline__ int moe_tile_table(Frame& F, int mi) {
    __syncthreads();
    if (F.tid == 0) { int acc = 0;
        for (int e = 0; e < 8; ++e) { F.MISC[32 + e] = (unsigned)acc; const unsigned c = __hip_atomic_load((unsigned*)(F.ctl() + CW_CNT + 64 * (mi * 8 + e)), __ATOMIC_RELAXED, __HIP_MEMORY_SCOPE_AGENT); acc += (int)((c + 255u) >> 8); }
        F.MISC[40] = (unsigned)acc; }
    __syncthreads();
    return (int)F.MISC[40];
}
__device__ __forceinline__ void moe_scatter(Frame& F, int mi) {
    (void)moe_tile_table(F, mi);
    const int gw = F.vcu * NWAVES + F.wave, NGW = F.G * NWAVES;
    const int4* TI = (const int4*)(F.ws() + WS_TOKINFO); int4* TS = (int4*)(F.ws() + WS_TOKSLOT);
    const bf16* H = (const bf16*)(F.ws() + WS_H); bf16* HP = (bf16*)(F.ws() + WS_HPERM);
    int rs[8];
#pragma unroll
    for (int e = 0; e < 8; ++e) rs[e] = (int)F.MISC[32 + e] * 256;
#if MOE_FP8
    { int* ST = (int*)(F.ws() + WS_SLOTTOK);
      for (int e = 0; e < 8; ++e) { const int cnt_e = (int)__hip_atomic_load((unsigned*)(F.ctl() + CW_CNT + 64 * (mi * 8 + e)), __ATOMIC_RELAXED, __HIP_MEMORY_SCOPE_AGENT);
          const int end_e = (int)F.MISC[32 + e + 1] * 256;
          for (int i = rs[e] + cnt_e + F.vcu * (NWAVES * 64) + F.tid; i < end_e; i += F.G * NWAVES * 64) ST[i] = 0; } }
#endif
    for (int item = gw; item < NTOK / 64; item += NGW) {
        const int tok = item * 64 + F.lane; const int4 ti = TI[tok];
        int s0 = 0, s1 = 0;
        unsigned base[8]; int rank[8];
#pragma unroll
        for (int e = 0; e < 8; ++e) {
            const bool has = (ti.x == e) || (ti.y == e);
            const unsigned long long mask = __ballot(has); const int n = __popcll(mask);
            base[e] = 0u;
            if (F.lane == 0 && n > 0) base[e] = __hip_atomic_fetch_add((unsigned*)(F.ctl() + CW_CUR + 64 * (mi * 8 + e)), (unsigned)n, __ATOMIC_RELAXED, __HIP_MEMORY_SCOPE_AGENT);
            rank[e] = __popcll(mask & ((1ull << F.lane) - 1ull));
        }
#pragma unroll
        for (int e = 0; e < 8; ++e) {
            const int slot = rs[e] + __builtin_amdgcn_readfirstlane((int)base[e]) + rank[e];
            if (ti.x == e) s0 = slot; if (ti.y == e) s1 = slot;
        }
        TS[tok] = make_int4(s0, s1, ti.z, ti.w);
#if MOE_FP8
        { int* ST = (int*)(F.ws() + WS_SLOTTOK); ST[s0] = tok; ST[s1] = tok; }
        for (int j = 0; j < 0; ++j) {
#else
        for (int j = 0; j < 64; ++j) {
#endif
            const int d0 = __builtin_amdgcn_readlane(s0, j), d1 = __builtin_amdgcn_readlane(s1, j);
#if MOE_FP8
            const v4u a = *((const v4u*)((const unsigned char*)H + (size_t)(item * 64 + j) * DM) + F.lane);
            *((v4u*)((unsigned char*)HP + (size_t)d0 * DM) + F.lane) = a; *((v4u*)((unsigned char*)HP + (size_t)d1 * DM) + F.lane) = a;
#else
            const v4u* src = (const v4u*)(H + (size_t)(item * 64 + j) * DM) + F.lane; const v4u a = src[0], b = src[64];
            v4u* q0 = (v4u*)(HP + (size_t)d0 * DM) + F.lane; v4u* q1 = (v4u*)(HP + (size_t)d1 * DM) + F.lane;
            q0[0] = a; q0[64] = b; q1[0] = a; q1[64] = b;
#endif
        }
    }
}

namespace fa {
typedef float f32x16 __attribute__((ext_vector_type(16)));
typedef short s16x4 __attribute__((ext_vector_type(4)));
typedef short v4i16_t __attribute__((ext_vector_type(4)));
constexpr float LOG2E = 1.4426950408889634f;
constexpr int KV_BUF = 16384;
constexpr int KV_RING = 5;
constexpr int OFF_WSF = KV_RING * KV_BUF;
constexpr int OFF_CNT = OFF_WSF + 2048;
constexpr int OFF_BT = OFF_CNT + 64;
constexpr int OFF_OST = 0;
constexpr int OST_ROW = 68, OST_WAVE = 32 * OST_ROW * 4;
static_assert(OFF_BT + 257 * 4 <= RING_BYTES && OFF_OST + 8 * OST_WAVE <= OFF_WSF, "attention LDS map");
#define C0R(r) (float)(((r) & 3) + 8 * ((r) >> 2))
__device__ __forceinline__ int crow(int r, int hi) { return (r & 3) + 8 * (r >> 2) + 4 * hi; }
struct TileRegs { v4u k, v; };
__device__ __forceinline__ void tile_load(TileRegs& R, const bf16* P, size_t row0, int kcol, int vcol, int tid_, int khi = 32) {
    int tid = tid_; asm volatile("" : "+v"(tid));
    const int key = tid >> 3, c = tid & 7;
    R.k = *(const v4u*)(P + (row0 + key) * INC + kcol + (c >> 2) * khi + (c & 3) * 8);
    R.v = *(const v4u*)(P + (row0 + key) * INC + vcol + c * 8);
}
__device__ __forceinline__ void tile_write(const TileRegs& R, LAS unsigned char* Kb, int tid_) {
    int tid = tid_; asm volatile("" : "+v"(tid));
    const int key = tid >> 3, c = tid & 7;
    *(LAS v4u*)(Kb + c * 1024 + key * 16) = R.k;
    *(LAS v4u*)(Kb + 8192 + ((c >> 2) * 4 + (key >> 4)) * 1024 + (key & 15) * 64 + (c & 3) * 16) = R.v;
}
__device__ __forceinline__ void tile_dma(const bf16* P, size_t row0, int kcol, int vcol, LAS unsigned char* Kb, int lane_, int w, int khi = 32) {
    int lane = lane_; asm volatile("" : "+v"(lane));
    const unsigned ko = (unsigned)(lane * INC + (w >> 2) * khi + (w & 3) * 8) * 2u;
    const unsigned vo = (unsigned)(((w & 3) * 16 + (lane >> 2)) * INC + (w >> 2) * 32 + (lane & 3) * 8) * 2u;
    const char* gk = (const char*)(P + row0 * INC + kcol); const char* gv = (const char*)(P + row0 * INC + vcol);
    __builtin_amdgcn_global_load_lds((const GAS unsigned*)(gk + ko), (LAS unsigned*)(Kb + w * 1024), 16, 0, 0);
    __builtin_amdgcn_global_load_lds((const GAS unsigned*)(gv + vo), (LAS unsigned*)(Kb + 8192 + w * 1024), 16, 0, 0);
}
__device__ __forceinline__ void tile_dma_wait() { asm volatile("s_waitcnt vmcnt(0)" ::: "memory"); }
__device__ __forceinline__ bf16x8 kfrag(const LAS unsigned char* Kb, int chunk, int key) { return *(const LAS bf16x8*)(Kb + chunk * 1024 + key * 16); }
__device__ __forceinline__ s16x4 vtr(const LAS unsigned char* p) { return __builtin_bit_cast(s16x4, __builtin_amdgcn_ds_read_tr16_b64_v4i16((LAS v4i16_t*)p)); }
__device__ __forceinline__ bf16x8 vfrag(const LAS unsigned char* vp, int d0, int ks) {
    const s16x4 lo = vtr(vp + d0 * 4096 + ks * 1024), hi = vtr(vp + d0 * 4096 + ks * 1024 + 512);
    return (bf16x8){lo[0], lo[1], lo[2], lo[3], hi[0], hi[1], hi[2], hi[3]};
}
__device__ __forceinline__ bf16x8 qfrag(const bf16* p, float scale) {
    const v4u a = *(const v4u*)p; v4u o;
    o.x = pk2(lo_bf(a.x) * scale, hi_bf(a.x) * scale); o.y = pk2(lo_bf(a.y) * scale, hi_bf(a.y) * scale);
    o.z = pk2(lo_bf(a.z) * scale, hi_bf(a.z) * scale); o.w = pk2(lo_bf(a.w) * scale, hi_bf(a.w) * scale);
    return __builtin_bit_cast(bf16x8, o);
}
__device__ __forceinline__ float swap_max(float m) { auto rr = __builtin_amdgcn_permlane32_swap(__float_as_uint(m), __float_as_uint(m), false, false); return fmaxf(__uint_as_float(rr[0]), __uint_as_float(rr[1])); }
__device__ __forceinline__ float swap_sum(float m) { auto rr = __builtin_amdgcn_permlane32_swap(__float_as_uint(m), __float_as_uint(m), false, false); return __uint_as_float(rr[0]) + __uint_as_float(rr[1]); }
__device__ __forceinline__ float max3f(float a, float b, float c) { float r; asm("v_max3_f32 %0, %1, %2, %3" : "=v"(r) : "v"(a), "v"(b), "v"(c)); return r; }
__device__ __forceinline__ float rowmax32(const f32x16& a, const f32x16& b) {
    float m0 = max3f(a[0], a[1], b[0]), m1 = max3f(a[2], a[3], b[1]); m0 = max3f(m0, b[2], b[3]);
#pragma unroll
    for (int r = 4; r < 16; r += 4) { m0 = max3f(m0, a[r], a[r + 1]); m1 = max3f(m1, a[r + 2], a[r + 3]); m0 = max3f(m0, b[r], b[r + 1]); m1 = max3f(m1, b[r + 2], b[r + 3]); }
    float m; asm("v_max_f32_e32 %0, %1, %2" : "=v"(m) : "v"(m0), "v"(m1));
    return swap_max(m);
}
__device__ __forceinline__ unsigned cvtpk(float lo, float hi) { typedef float f2 __attribute__((ext_vector_type(2))); typedef __bf16 b2 __attribute__((ext_vector_type(2))); f2 v = {lo, hi}; b2 b = __builtin_convertvector(v, b2); return __builtin_bit_cast(unsigned, b); }
__device__ __forceinline__ void pack_p(const f32x16& p0, const f32x16& p1, bf16x8 (&pa)[4]) {
    v4u w;
    w.x = cvtpk(p0[0], p0[1]); w.y = cvtpk(p0[2], p0[3]); w.z = cvtpk(p0[4], p0[5]); w.w = cvtpk(p0[6], p0[7]); pa[0] = __builtin_bit_cast(bf16x8, w);
    w.x = cvtpk(p0[8], p0[9]); w.y = cvtpk(p0[10], p0[11]); w.z = cvtpk(p0[12], p0[13]); w.w = cvtpk(p0[14], p0[15]); pa[1] = __builtin_bit_cast(bf16x8, w);
    w.x = cvtpk(p1[0], p1[1]); w.y = cvtpk(p1[2], p1[3]); w.z = cvtpk(p1[4], p1[5]); w.w = cvtpk(p1[6], p1[7]); pa[2] = __builtin_bit_cast(bf16x8, w);
    w.x = cvtpk(p1[8], p1[9]); w.y = cvtpk(p1[10], p1[11]); w.z = cvtpk(p1[12], p1[13]); w.w = cvtpk(p1[14], p1[15]); pa[3] = __builtin_bit_cast(bf16x8, w);
}
#if WOUT_I8
#define MIXPTR(row, col) ((bf16*)(F.ws() + WS_MIX + (size_t)(row) * DM + (col)))
#else
#define MIXPTR(row, col) ((bf16*)(F.ws() + WS_MIX) + (size_t)(row) * DM + (col))
#endif
__device__ __forceinline__ void stage_store(Frame& F, const LAS float* stg, const float* g, float hscale, bf16* dst  ) {
    const int c8 = F.lane & 7;
    float gg[8];
#pragma unroll
    for (int j = 0; j < 8; ++j) gg[j] = g[c8 * 8 + j];
#pragma unroll
    for (int i4 = 0; i4 < 4; ++i4) { const int row = i4 * 8 + (F.lane >> 3);
        const f32x4 a = *(const LAS f32x4*)(stg + row * OST_ROW + c8 * 8), b = *(const LAS f32x4*)(stg + row * OST_ROW + c8 * 8 + 4);
        float ss = (a.x * a.x + a.y * a.y) + (a.z * a.z + a.w * a.w) + (b.x * b.x + b.y * b.y) + (b.z * b.z + b.w * b.w);
        ss += shx(ss, 1, F.lane); ss += shx(ss, 2, F.lane); ss += shx(ss, 4, F.lane);
#if WOUT_I8
        const float rs = (127.0f / 8.0f) / sqrtf(ss * (1.0f / 64.0f) + EPS);
        v2u w; w.x = pack4_i8(a.x * rs, a.y * rs, a.z * rs, a.w * rs); w.y = pack4_i8(b.x * rs, b.y * rs, b.z * rs, b.w * rs);
        *(v2u*)((unsigned char*)dst + (size_t)row * DM + c8 * 8) = w; }
#else
        const float rs = hscale / sqrtf(ss * (1.0f / 64.0f) + EPS);
        v4u w; w.x = pk2(a.x * rs * gg[0], a.y * rs * gg[1]); w.y = pk2(a.z * rs * gg[2], a.w * rs * gg[3]); w.z = pk2(b.x * rs * gg[4], b.y * rs * gg[5]); w.w = pk2(b.z * rs * gg[6], b.w * rs * gg[7]);
        *(v4u*)(dst + (size_t)row * DM + c8 * 8) = w; }
#endif
}

__device__ __forceinline__ void df_unit(Frame& F, int layer, int b, int h, int qb) {
    const int lane = F.lane, r32 = lane & 31, hi = lane >> 5, w = F.wave, tid = F.tid;
    const size_t rowb = (size_t)b * SEQ; const int q0 = qb * 256;
    const bf16* P = (const bf16*)(F.ws() + WS_PROJ);
    const int qpos = q0 + 32 * w + r32, cq = (q0 + 32 * w) >> 6;
    const float slope2 = exp2f(-2.0f * (float)(h + 1)) * LOG2E;
    LAS float* wsf = (LAS float*)(F.lds + OFF_WSF) + w * 64;
    LAS unsigned* cnt = (LAS unsigned*)(F.lds + OFF_CNT);
    bf16x8 qr[2][2];
#pragma unroll
    for (int i = 0; i < 2; ++i)
#pragma unroll
        for (int d = 0; d < 2; ++d) qr[i][d] = qfrag(P + (rowb + qpos) * INC + C_QDF + h * 64 + i * 32 + d * 16 + hi * 8, 0.17677669529663687f * LOG2E);
    float smax2;
    { float gq = 0.f, gk = 0.f; const float* pq = F.in[16] + layer * 64; const float* pk = F.in[17] + layer * 64;
      for (int d = 0; d < 64; ++d) { gq = fmaxf(gq, fabsf(pq[d])); gk = fmaxf(gk, fabsf(pk[d])); }
      smax2 = 5.656854249492381f * gq * gk * LOG2E * 1.05f; }
    const float mref = smax2 + slope2 * (float)qpos;
    float l[2] = {0.f, 0.f};
    f32x16 o[2][2];
#pragma unroll
    for (int i = 0; i < 2; ++i)
#pragma unroll
        for (int d = 0; d < 2; ++d) o[i][d] = (f32x16){};
    const int ktop = qb * 4 + 3, kcol = C_KDF + h * 64, vcol = C_VDF + h * 64;
    __syncthreads();
#pragma unroll
    for (int j = 0; j < 4; ++j) tile_dma(P, rowb + (size_t)(ktop - j) * 64, kcol, vcol, F.lds + j * KV_BUF, lane, w);
    tile_dma_wait();
    if (tid < 3) cnt[tid] = 0u;
    __syncthreads();
    bool done_w = false;
    for (int it = 0; ; ++it) {
        const int kc = cq - it;
        const LAS unsigned char* Kb = F.lds + ((ktop - cq + it) % KV_RING) * KV_BUF; const LAS unsigned char* Vb = Kb + 8192;
        if (ktop - 4 - it >= 0) tile_dma(P, rowb + (size_t)(ktop - 4 - it) * 64, kcol, vcol, F.lds + ((it + 4) % KV_RING) * KV_BUF, lane, w);
        if (kc >= 0 && !done_w) {
            bf16x8 pa[2][4];
#pragma unroll
            for (int i = 0; i < 2; ++i) {
                const float sc = slope2 * (float)(kc * 64 + 4 * hi) - mref;
                f32x16 p0, p1;
#pragma unroll
                for (int r = 0; r < 16; ++r) { p0[r] = slope2 * C0R(r) + sc; p1[r] = p0[r] + 32.0f * slope2; }
                p0 = __builtin_amdgcn_mfma_f32_32x32x16_bf16(kfrag(Kb, i * 4 + hi, r32), qr[i][0], p0, 0, 0, 0);
                p0 = __builtin_amdgcn_mfma_f32_32x32x16_bf16(kfrag(Kb, i * 4 + 2 + hi, r32), qr[i][1], p0, 0, 0, 0);
                p1 = __builtin_amdgcn_mfma_f32_32x32x16_bf16(kfrag(Kb, i * 4 + hi, r32 + 32), qr[i][0], p1, 0, 0, 0);
                p1 = __builtin_amdgcn_mfma_f32_32x32x16_bf16(kfrag(Kb, i * 4 + 2 + hi, r32 + 32), qr[i][1], p1, 0, 0, 0);
                if (it == 0) {
                    const float qrel = (float)(qpos - kc * 64 - 4 * hi), s2 = 2.0f * slope2;
#pragma unroll
                    for (int r = 0; r < 16; ++r) { const float d0 = C0R(r) - qrel; p0[r] -= s2 * fmaxf(d0, 0.f); p1[r] -= s2 * fmaxf(d0 + 32.0f, 0.f); }
                }
                float ssum = 0.f;
#pragma unroll
                for (int r = 0; r < 16; ++r) { p0[r] = __builtin_amdgcn_exp2f(p0[r]); p1[r] = __builtin_amdgcn_exp2f(p1[r]); ssum += p0[r] + p1[r]; }
                l[i] += ssum;
                pack_p(p0, p1, pa[i]);
            }
            const LAS unsigned char* vp = Vb + ((lane >> 4) & 1) * 32 + (lane & 3) * 8 + (4 * hi + ((lane & 15) >> 2)) * 64;
#pragma unroll
            for (int d0 = 0; d0 < 2; ++d0)
#pragma unroll
                for (int ks = 0; ks < 4; ++ks) { const bf16x8 vf = vfrag(vp, d0, ks);
                    o[0][d0] = __builtin_amdgcn_mfma_f32_32x32x16_bf16(pa[0][ks], vf, o[0][d0], 0, 0, 0);
                    o[1][d0] = __builtin_amdgcn_mfma_f32_32x32x16_bf16(pa[1][ks], vf, o[1][d0], 0, 0, 0); }
            const float lrow = fminf(swap_sum(l[0]), swap_sum(l[1]));
            done_w = __all(slope2 * (float)(kc * 64 - 1 - qpos) + 37.0f < __builtin_amdgcn_logf(lrow)) != 0;
        }
        if (kc <= 0) done_w = true;
        if (lane == 0 && done_w) __hip_atomic_fetch_add(cnt + (it % 3), 1u, __ATOMIC_RELAXED, __HIP_MEMORY_SCOPE_WORKGROUP);
        if (tid == 0) cnt[(it + 1) % 3] = 0u;
        tile_dma_wait();
        __syncthreads();
        const unsigned c = cnt[it % 3];
        if (c == 8u) break;
    }
    int lane_f = lane; asm volatile("" : "+v"(lane_f)); const int r32f = lane_f & 31, hif = lane_f >> 5;
    const float* lp = F.in[18] + layer * 128; float sa = 0.f, sb = 0.f;
    for (int d = 0; d < 32; ++d) { sa += lp[d] * lp[32 + d]; sb += lp[64 + d] * lp[96 + d]; }
    const float lam_init = 0.8f - 0.6f * expf(-0.3f * (float)layer);
    const float lam = expf(sa) - expf(sb) + lam_init;
    const float l0 = swap_sum(l[0]), l1 = swap_sum(l[1]);
    asm volatile("" ::: "memory");
    if (hif == 0) { wsf[r32f] = 1.0f / l0; wsf[32 + r32f] = -lam / l1; }
    asm volatile("s_waitcnt lgkmcnt(0)" ::: "memory");
    LAS float* stg = (LAS float*)(F.lds + OFF_OST + w * OST_WAVE);
#pragma unroll
    for (int r = 0; r < 16; ++r) { const int row = crow(r, hif); const float a0 = wsf[row], a1 = wsf[32 + row];
        stg[row * OST_ROW + r32f] = o[0][0][r] * a0 + o[1][0][r] * a1; stg[row * OST_ROW + 32 + r32f] = o[0][1][r] * a0 + o[1][1][r] * a1; }
    asm volatile("s_waitcnt lgkmcnt(0)" ::: "memory");
    { Frame F2 = F; F2.lane = lane_f; stage_store(F2, stg, F.in[19] + layer * DM + 768 + h * 64, 1.0f - lam_init, MIXPTR(rowb + q0 + 32 * w, 768 + h * 64)); }
    __syncthreads();
}

__device__ __forceinline__ void sb_unit(Frame& F, int layer, int b, int h, int qb) {
    const int lane = F.lane, r32 = lane & 31, hi = lane >> 5, w = F.wave, tid = F.tid;
    const size_t rowb = (size_t)b * SEQ; const int q0 = qb * 256;
    const bf16* P = (const bf16*)(F.ws() + WS_PROJ);
    const int qpos = q0 + 32 * w + r32, cq = (q0 + 32 * w) >> 6;
    LAS unsigned* cnt = (LAS unsigned*)(F.lds + OFF_CNT);
    bf16x8 qr[4];
#pragma unroll
    for (int d = 0; d < 4; ++d) qr[d] = qfrag(P + (rowb + qpos) * INC + C_QSB + h * 64 + d * 16 + hi * 8, 0.125f * LOG2E);
    bf16x8 U0, U1, ONES;
#pragma unroll
    for (int e = 0; e < 8; ++e) { const int j0 = 8 * (e >> 2) + 4 * hi + (e & 3); U0[e] = (short)((j0 > r32) ? 0x3F80 : 0); U1[e] = (short)((16 + j0 > r32) ? 0x3F80 : 0); ONES[e] = (short)0x3F80; }
    float run = 0.f;
    f32x16 o[2]; o[0] = (f32x16){}; o[1] = (f32x16){};
    const int ktop = qb * 4 + 3, kcol = C_KSB + h * 64, vcol = C_VSB + h * 64;
    __syncthreads();
#pragma unroll
    for (int j = 0; j < 4; ++j) tile_dma(P, rowb + (size_t)(ktop - j) * 64, kcol, vcol, F.lds + j * KV_BUF, lane, w);
    tile_dma_wait();
    if (tid < 3) cnt[tid] = 0u;
    __syncthreads();
    bool done_w = false;
    for (int it = 0; ; ++it) {
        const int kc = cq - it;
        const LAS unsigned char* Kb = F.lds + ((ktop - cq + it) % KV_RING) * KV_BUF; const LAS unsigned char* Vb = Kb + 8192;
        if (ktop - 4 - it >= 0) tile_dma(P, rowb + (size_t)(ktop - 4 - it) * 64, kcol, vcol, F.lds + ((it + 4) % KV_RING) * KV_BUF, lane, w);
        if (kc >= 0 && !done_w) {
            f32x16 p0 = (f32x16){}, p1 = (f32x16){};
#pragma unroll
            for (int d = 0; d < 4; ++d) { p0 = __builtin_amdgcn_mfma_f32_32x32x16_bf16(kfrag(Kb, d * 2 + hi, r32), qr[d], p0, 0, 0, 0);
                                          p1 = __builtin_amdgcn_mfma_f32_32x32x16_bf16(kfrag(Kb, d * 2 + hi, r32 + 32), qr[d], p1, 0, 0, 0); }
            f32x16 m0, m1;
#pragma unroll
            for (int r = 0; r < 16; ++r) {
                { const float z = p0[r]; const float sp = fmaxf(z, 0.f) + __builtin_amdgcn_logf(1.0f + __builtin_amdgcn_exp2f(-fabsf(z))); m0[r] = -sp; p0[r] = z - sp; }
                { const float z = p1[r]; const float sp = fmaxf(z, 0.f) + __builtin_amdgcn_logf(1.0f + __builtin_amdgcn_exp2f(-fabsf(z))); m1[r] = -sp; p1[r] = z - sp; }
            }
            if (it == 0) {
                const float qrel = (float)(qpos - kc * 64 - 4 * hi);
#pragma unroll
                for (int r = 0; r < 16; ++r) { const bool v0 = C0R(r) < qrel, v1 = C0R(r) + 32.0f < qrel; m0[r] = v0 ? m0[r] : 0.f; p0[r] = v0 ? p0[r] : -1.0e30f; m1[r] = v1 ? m1[r] : 0.f; p1[r] = v1 ? p1[r] : -1.0e30f; }
            }
            float tsum = 0.f;
#pragma unroll
            for (int r = 0; r < 16; ++r) tsum += m0[r] + m1[r];
            bf16x8 lb[4]; pack_p(m0, m1, lb);
            f32x16 b0, b1;
#pragma unroll
            for (int r = 0; r < 16; ++r) { b0[r] = run; b1[r] = run; }
            b0 = __builtin_amdgcn_mfma_f32_32x32x16_bf16(U0, lb[0], b0, 0, 0, 0); b0 = __builtin_amdgcn_mfma_f32_32x32x16_bf16(U1, lb[1], b0, 0, 0, 0);
            b0 = __builtin_amdgcn_mfma_f32_32x32x16_bf16(ONES, lb[2], b0, 0, 0, 0); b0 = __builtin_amdgcn_mfma_f32_32x32x16_bf16(ONES, lb[3], b0, 0, 0, 0);
            b1 = __builtin_amdgcn_mfma_f32_32x32x16_bf16(U0, lb[2], b1, 0, 0, 0); b1 = __builtin_amdgcn_mfma_f32_32x32x16_bf16(U1, lb[3], b1, 0, 0, 0);
#pragma unroll
            for (int r = 0; r < 16; ++r) { p0[r] = __builtin_amdgcn_exp2f(p0[r] + b0[r]); p1[r] = __builtin_amdgcn_exp2f(p1[r] + b1[r]); }
            run += swap_sum(tsum);
            bf16x8 pa[4]; pack_p(p0, p1, pa);
            const LAS unsigned char* vp = Vb + ((lane >> 4) & 1) * 32 + (lane & 3) * 8 + (4 * hi + ((lane & 15) >> 2)) * 64;
#pragma unroll
            for (int d0 = 0; d0 < 2; ++d0)
#pragma unroll
                for (int ks = 0; ks < 4; ++ks) o[d0] = __builtin_amdgcn_mfma_f32_32x32x16_bf16(pa[ks], vfrag(vp, d0, ks), o[d0], 0, 0, 0);
            done_w = __all(run < -150.0f) != 0;
        }
        if (kc <= 0) done_w = true;
        if (lane == 0 && done_w) __hip_atomic_fetch_add(cnt + (it % 3), 1u, __ATOMIC_RELAXED, __HIP_MEMORY_SCOPE_WORKGROUP);
        if (tid == 0) cnt[(it + 1) % 3] = 0u;
        tile_dma_wait();
        __syncthreads();
        const unsigned c = cnt[it % 3];
        if (c == 8u) break;
    }
    int lane_f = lane; asm volatile("" : "+v"(lane_f)); const int r32f = lane_f & 31, hif = lane_f >> 5;
    LAS float* stg = (LAS float*)(F.lds + OFF_OST + w * OST_WAVE);
#pragma unroll
    for (int r = 0; r < 16; ++r) { const int row = crow(r, hif); stg[row * OST_ROW + r32f] = o[0][r]; stg[row * OST_ROW + 32 + r32f] = o[1][r]; }
    asm volatile("s_waitcnt lgkmcnt(0)" ::: "memory");
    { Frame F2 = F; F2.lane = lane_f; stage_store(F2, stg, F.in[19] + layer * DM + 256 + h * 64, 1.0f, MIXPTR(rowb + q0 + 32 * w, 256 + h * 64)); }
    __syncthreads();
}

__device__ __forceinline__ void ch_unit(Frame& F, int layer, int b, int h, int blk) {
    const int lane = F.lane, r32 = lane & 31, hi = lane >> 5, w = F.wave, tid = F.tid;
    const size_t rowb = (size_t)b * SEQ; const int q0 = blk * 256;
    const bf16* P = (const bf16*)(F.ws() + WS_PROJ);
    const int qpos = q0 + 32 * w + r32, cq = (q0 + 32 * w) >> 6;
    LAS float* wsf = (LAS float*)(F.lds + OFF_WSF) + w * 64;
    LAS float* bt = (LAS float*)(F.lds + OFF_BT);
    bf16x8 qr[4];
#pragma unroll
    for (int d = 0; d < 4; ++d) qr[d] = qfrag(P + (rowb + qpos) * INC + C_QCH + (d >> 1) * 128 + 32 * h + (d & 1) * 16 + hi * 8, 0.125f * LOG2E);
    float l = 0.f;
    f32x16 o[2]; o[0] = (f32x16){}; o[1] = (f32x16){};
    const int ktop = blk * 4 + 3, kcol = C_KCH + 32 * h, vcol = C_VCH + h * 64;
    __syncthreads();
#pragma unroll
    for (int j = 0; j < 4; ++j) tile_dma(P, rowb + (size_t)(ktop - j) * 64, kcol, vcol, F.lds + j * KV_BUF, lane, w, 128);
    tile_dma_wait();
    if (tid < 257) bt[tid] = F.in[15][(layer * 4 + h) * 257 + tid] * LOG2E;
    __syncthreads();
    const float bfar = bt[256];
    float mref;
    { float gq = 0.f, gk = 0.f; const float* pq = F.in[13] + layer * 64; const float* pk = F.in[14] + layer * 64;
      for (int d = 0; d < 64; ++d) { gq = fmaxf(gq, fabsf(pq[d])); gk = fmaxf(gk, fabsf(pk[d])); }
      float bm = fmaxf(fmaxf(bt[lane], bt[lane + 64]), fmaxf(bt[lane + 128], bt[lane + 192])); bm = fmaxf(bm, bt[256]);
#pragma unroll
      for (int o_ = 1; o_ < 64; o_ <<= 1) bm = fmaxf(bm, shx(bm, o_, lane));
      mref = 8.0f * gq * gk * LOG2E * 1.05f + bm; }
    for (int it = 0; ; ++it) {
        const int kc = cq - it;
        const LAS unsigned char* Kb = F.lds + ((ktop - cq + it) % KV_RING) * KV_BUF; const LAS unsigned char* Vb = Kb + 8192;
        if (it < 8 && ktop - 4 - it >= 0) tile_dma(P, rowb + (size_t)(ktop - 4 - it) * 64, kcol, vcol, F.lds + ((it + 4) % KV_RING) * KV_BUF, lane, w, 128);
        if (kc >= 0) {
            const bool nearT = it <= 2;
            const float ini = (nearT ? 0.f : bfar) - mref;
            f32x16 p0, p1;
#pragma unroll
            for (int r = 0; r < 16; ++r) { p0[r] = ini; p1[r] = ini; }
#pragma unroll
            for (int d = 0; d < 4; ++d) { p0 = __builtin_amdgcn_mfma_f32_32x32x16_bf16(kfrag(Kb, d * 2 + hi, r32), qr[d], p0, 0, 0, 0);
                                          p1 = __builtin_amdgcn_mfma_f32_32x32x16_bf16(kfrag(Kb, d * 2 + hi, r32 + 32), qr[d], p1, 0, 0, 0); }
            if (nearT) {
                const int qrel = qpos - kc * 64 - 4 * hi + 128;
#pragma unroll
                for (int r = 0; r < 16; ++r) { int i0 = qrel - ((r & 3) + 8 * (r >> 2)); int i1 = i0 - 32;
                    i0 = i0 < 0 ? 0 : (i0 > 256 ? 256 : i0); i1 = i1 < 0 ? 0 : (i1 > 256 ? 256 : i1); p0[r] += bt[i0]; p1[r] += bt[i1]; }
            }
            float ssum = 0.f;
#pragma unroll
            for (int r = 0; r < 16; ++r) { p0[r] = __builtin_amdgcn_exp2f(p0[r]); p1[r] = __builtin_amdgcn_exp2f(p1[r]); ssum += p0[r] + p1[r]; }
            l += ssum;
            bf16x8 pa[4]; pack_p(p0, p1, pa);
            const LAS unsigned char* vp = Vb + ((lane >> 4) & 1) * 32 + (lane & 3) * 8 + (4 * hi + ((lane & 15) >> 2)) * 64;
#pragma unroll
            for (int d0 = 0; d0 < 2; ++d0)
#pragma unroll
                for (int ks = 0; ks < 4; ++ks) o[d0] = __builtin_amdgcn_mfma_f32_32x32x16_bf16(pa[ks], vfrag(vp, d0, ks), o[d0], 0, 0, 0);
        }
        tile_dma_wait();
        __syncthreads();
        if (it == 8) break;
    }
    int lane_f = lane; asm volatile("" : "+v"(lane_f)); const int r32f = lane_f & 31, hif = lane_f >> 5;
    const float lt = swap_sum(l);
    asm volatile("" ::: "memory");
    if (hif == 0) wsf[r32f] = 1.0f / lt;
    asm volatile("s_waitcnt lgkmcnt(0)" ::: "memory");
    LAS float* stg = (LAS float*)(F.lds + OFF_OST + w * OST_WAVE);
#pragma unroll
    for (int r = 0; r < 16; ++r) { const int row = crow(r, hif); const float a = wsf[row]; stg[row * OST_ROW + r32f] = o[0][r] * a; stg[row * OST_ROW + 32 + r32f] = o[1][r] * a; }
    asm volatile("s_waitcnt lgkmcnt(0)" ::: "memory");
    { Frame F2 = F; F2.lane = lane_f; stage_store(F2, stg, F.in[19] + layer * DM + 512 + h * 64, 1.0f, MIXPTR(rowb + q0 + 32 * w, 512 + h * 64)); }
    __syncthreads();
}
#undef C0R
}

__device__ __forceinline__ void sincos_acc(double th, float& s, float& c) {
    double r = th * 0.15915494309189535; r -= __builtin_rint(r);
    double a = r * 6.283185307179586;
    const double k = __builtin_rint(a * 0.6366197723675814);
    const double f = a - k * 1.5707963267948966, f2 = f * f;
    double sp = f * (1.0 + f2 * (-1.0 / 6 + f2 * (1.0 / 120 + f2 * (-1.0 / 5040 + f2 * (1.0 / 362880 + f2 * (-1.0 / 39916800 + f2 * (1.0 / 6227020800.0)))))));
    double cp = 1.0 + f2 * (-0.5 + f2 * (1.0 / 24 + f2 * (-1.0 / 720 + f2 * (1.0 / 40320 + f2 * (-1.0 / 3628800 + f2 * (1.0 / 479001600.0 + f2 * (-1.0 / 87178291200.0)))))));
    const int ki = ((int)k) & 3;
    double ss = sp, cc = cp;
    if (ki == 1) { ss = cp; cc = -sp; } else if (ki == 2) { ss = -sp; cc = -cp; } else if (ki == 3) { ss = -cp; cc = sp; }
    s = (float)ss; c = (float)cc;
}
__device__ __forceinline__ void ssm_prep(Frame& F) {
    const int idx = F.vcu * (NWAVES * 64) + F.tid;
    if (idx < DEPTH * 16 * 64) {
        const int gi = idx >> 6;
        const float lre = F.in[3][idx], lim = F.in[4][idx], dt = expf(F.in[5][gi]);
        float sn, cs; sincos_acc((double)lim * (double)dt, sn, cs);
        const float mag = expf(lre * dt); const float lbr = mag * cs, lbi = mag * sn;
        const float nr = lbr - 1.0f, ni = lbi, den = lre * lre + lim * lim;
        *((f32x4*)(F.ws() + WS_SSMP) + idx) = (f32x4){lbr, lbi, (nr * lre + ni * lim) / den, (ni * lre - nr * lim) / den};
    }
}
constexpr size_t WS_SSMS = WS_SSMY;
constexpr size_t WS_SSMH = WS_SSMY + 4 * MiB;
constexpr size_t WS_WGT = 1 * MiB + 65536;
struct SsmPar { float lbr, lbi; bf16x8 bt[4]; };
__device__ __forceinline__ void ssm_load_par(Frame& F, int layer, int g, SsmPar& p) {
    const int gi = layer * 16 + g, r32 = F.lane & 31, hi = F.lane >> 5;
    const f32x4 own = *((const f32x4*)(F.ws() + WS_SSMP) + gi * 64 + F.lane + F.vz);
    p.lbr = own.x; p.lbi = own.y;
#pragma unroll
    for (int nh = 0; nh < 2; ++nh) { const int n = 32 * nh + r32;
        const f32x4 sp4 = *((const f32x4*)(F.ws() + WS_SSMP) + gi * 64 + n + F.vz);
        const f32x4 r0 = *(const f32x4*)(F.in[6] + (gi * 64 + n) * 16 + 8 * hi), r1 = *(const f32x4*)(F.in[6] + (gi * 64 + n) * 16 + 8 * hi + 4);
        const f32x4 i0 = *(const f32x4*)(F.in[7] + (gi * 64 + n) * 16 + 8 * hi), i1 = *(const f32x4*)(F.in[7] + (gi * 64 + n) * 16 + 8 * hi + 4);
        v4u tr, ti;
        tr.x = pk2(sp4.z * r0.x - sp4.w * i0.x, sp4.z * r0.y - sp4.w * i0.y); tr.y = pk2(sp4.z * r0.z - sp4.w * i0.z, sp4.z * r0.w - sp4.w * i0.w);
        tr.z = pk2(sp4.z * r1.x - sp4.w * i1.x, sp4.z * r1.y - sp4.w * i1.y); tr.w = pk2(sp4.z * r1.z - sp4.w * i1.z, sp4.z * r1.w - sp4.w * i1.w);
        ti.x = pk2(sp4.z * i0.x + sp4.w * r0.x, sp4.z * i0.y + sp4.w * r0.y); ti.y = pk2(sp4.z * i0.z + sp4.w * r0.z, sp4.z * i0.w + sp4.w * r0.w);
        ti.z = pk2(sp4.z * i1.x + sp4.w * r1.x, sp4.z * i1.y + sp4.w * r1.y); ti.w = pk2(sp4.z * i1.z + sp4.w * r1.z, sp4.z * i1.w + sp4.w * r1.w);
        p.bt[2 * nh] = __builtin_bit_cast(bf16x8, tr); p.bt[2 * nh + 1] = __builtin_bit_cast(bf16x8, ti); }
}
__device__ __forceinline__ void ssm_x32(Frame& F, const SsmPar& p, const bf16* P, size_t row, int g, fa::f32x16& xr_a, fa::f32x16& xr_b, fa::f32x16& xi_a, fa::f32x16& xi_b) {
    const int r32 = F.lane & 31, hi = F.lane >> 5;
    const bf16x8 ua = *(const bf16x8*)(P + (row + r32) * INC + C_U + g * 16 + 8 * hi);
    const fa::f32x16 z = (fa::f32x16){};
    xr_a = __builtin_amdgcn_mfma_f32_32x32x16_bf16(ua, p.bt[0], z, 0, 0, 0); xi_a = __builtin_amdgcn_mfma_f32_32x32x16_bf16(ua, p.bt[1], z, 0, 0, 0);
    xr_b = __builtin_amdgcn_mfma_f32_32x32x16_bf16(ua, p.bt[2], z, 0, 0, 0); xi_b = __builtin_amdgcn_mfma_f32_32x32x16_bf16(ua, p.bt[3], z, 0, 0, 0);
#pragma unroll
    for (int r = 0; r < 16; ++r) {
        { auto q = __builtin_amdgcn_permlane32_swap(__float_as_uint(xr_a[r]), __float_as_uint(xr_b[r]), false, false); xr_a[r] = __uint_as_float(q[0]); xr_b[r] = __uint_as_float(q[1]); }
        { auto q = __builtin_amdgcn_permlane32_swap(__float_as_uint(xi_a[r]), __float_as_uint(xi_b[r]), false, false); xi_a[r] = __uint_as_float(q[0]); xi_b[r] = __uint_as_float(q[1]); }
    }
}
#define SSM_XR(t) ((((t) >> 2) & 1) ? xr_b[((t) & 3) + 4 * ((t) >> 3)] : xr_a[((t) & 3) + 4 * ((t) >> 3)])
#define SSM_XI(t) ((((t) >> 2) & 1) ? xi_b[((t) & 3) + 4 * ((t) >> 3)] : xi_a[((t) & 3) + 4 * ((t) >> 3)])
__device__ __forceinline__ void ssm_pass1(Frame& F, int layer) {
    const int gw = F.vcu * NWAVES + F.wave, NGW = F.G * NWAVES, n = F.lane;
    const bf16* P = (const bf16*)(F.ws() + WS_PROJ); f32x2* S = (f32x2*)(F.ws() + WS_SSMS);
    const bool xb = (F.G == 256);
    for (int u_ = gw; u_ < BATCH * 64 * 16; u_ += NGW) {
        const int u = xb ? ((((u_ & 2047) >> 8) << 10) + (u_ & 255) + 256 * (u_ >> 11)) : u_;
        const int g = u & 15, c = (u >> 4) & 63, b = u >> 10;
        SsmPar p; ssm_load_par(F, layer, g, p);
        float hr = 0.f, hi = 0.f;
        const size_t row0 = (size_t)b * SEQ + (size_t)c * 64;
#pragma nounroll
        for (int blk = 0; blk < 2; ++blk) {
            fa::f32x16 xr_a, xr_b, xi_a, xi_b; ssm_x32(F, p, P, row0 + blk * 32, g, xr_a, xr_b, xi_a, xi_b);
#pragma unroll
            for (int t = 0; t < 32; ++t) { const float nhr = p.lbr * hr - p.lbi * hi + SSM_XR(t), nhi = p.lbr * hi + p.lbi * hr + SSM_XI(t); hr = nhr; hi = nhi; }
        }
        S[(size_t)u * 64 + n] = (f32x2){hr, hi};
    }
}
constexpr int S2_Y2 = 0, S2_Y2ROW = 264  , S2_HST = 34816, S2_OUT = 34816, S2_OUTROW = 260  ;
static_assert(S2_Y2 + 64 * S2_Y2ROW * 2 <= S2_HST && S2_HST + 8 * 4096 <= RING_BYTES && S2_OUT + 64 * S2_OUTROW * 4 <= RING_BYTES, "ssm pass-2 LDS map");
__device__ __forceinline__ void ssm_pass2_unit(Frame& F, int layer, int b, int c) {
    const int lane = F.lane, w = F.wave, n = lane;
    const bf16* P = (const bf16*)(F.ws() + WS_PROJ);
    const size_t row0 = (size_t)b * SEQ + (size_t)c * 64;
    LAS unsigned* hst = (LAS unsigned*)(F.lds + S2_HST + w * 4096);
    LAS bf16* y2 = (LAS bf16*)(F.lds + S2_Y2);
    __syncthreads();
#pragma unroll
    for (int gg = 0; gg < 2; ++gg) {
        const int g = 2 * w + gg, gi = layer * 16 + g;
        SsmPar p; ssm_load_par(F, layer, g, p);
        bf16x8 ca[4];
        { const int pr = lane & 15, a4 = lane >> 4;
#pragma unroll
          for (int ks = 0; ks < 4; ++ks) { const f32x4 cr = *(const f32x4*)(F.in[8] + (gi * 16 + pr) * 64 + 16 * ks + 4 * a4), ci = *(const f32x4*)(F.in[9] + (gi * 16 + pr) * 64 + 16 * ks + 4 * a4);
              v4u t; t.x = pk2(cr.x, -ci.x); t.y = pk2(cr.y, -ci.y); t.z = pk2(cr.z, -ci.z); t.w = pk2(cr.w, -ci.w); ca[ks] = __builtin_bit_cast(bf16x8, t); } }
        float hr = 0.f, hi = 0.f;
        {
            float ar = p.lbr, ai = p.lbi;
#pragma unroll
            for (int k = 0; k < 6; ++k) { const float tr = ar * ar - ai * ai, ti = 2.0f * ar * ai; ar = tr; ai = ti; }
            const f32x2* Sg = (const f32x2*)(F.ws() + WS_SSMS) + ((size_t)(b * 64) * 16 + g) * 64 + n + F.vz;
#pragma nounroll
            for (int c0 = 0; c0 < c; c0 += 32) {
                f32x2 sv[32];
#pragma unroll
                for (int k = 0; k < 32; ++k) { const int cc = (c0 + k < 64) ? c0 + k : 63; sv[k] = Sg[(size_t)cc * 1024]; }
#pragma unroll
                for (int k = 0; k < 32; ++k) { const bool ok = c0 + k < c; const float nr = ar * hr - ai * hi + sv[k].x, ni = ar * hi + ai * hr + sv[k].y; hr = ok ? nr : hr; hi = ok ? ni : hi; }
            }
        }
        const f32x4 dsk = *(const f32x4*)(F.in[10] + layer * 256 + g * 16 + 4 * (lane >> 4));
#pragma nounroll
        for (int blk2 = 0; blk2 < 2; ++blk2) {
          fa::f32x16 xr_a, xr_b, xi_a, xi_b; ssm_x32(F, p, P, row0 + blk2 * 32, g, xr_a, xr_b, xi_a, xi_b);
#pragma unroll
          for (int half = 0; half < 2; ++half) {
            const int blk = blk2 * 2 + half;
#pragma unroll
            for (int k = 0; k < 16; ++k) { const int t = half * 16 + k; const float nhr = p.lbr * hr - p.lbi * hi + SSM_XR(t), nhi = p.lbr * hi + p.lbi * hr + SSM_XI(t); hr = nhr; hi = nhi;
                hst[k * 64 + n] = fa::cvtpk(hr, hi); }
            asm volatile("s_waitcnt lgkmcnt(0)" ::: "memory");
            f32x4 acc = (f32x4){0.f, 0.f, 0.f, 0.f};
#pragma unroll
            for (int ks = 0; ks < 4; ++ks) { const bf16x8 hb = *(const LAS bf16x8*)(hst + (lane & 15) * 64 + 16 * ks + 4 * (lane >> 4));
                acc = __builtin_amdgcn_mfma_f32_16x16x32_bf16(ca[ks], hb, acc, 0, 0, 0); }
            const int tok = blk * 16 + (lane & 15), ch = g * 16 + 4 * (lane >> 4);
            const v2u uu = *((const v2u*)(P + (row0 + tok) * INC + C_U + ch));
            float y[4]; y[0] = acc[0] + dsk.x * lo_bf(uu.x); y[1] = acc[1] + dsk.y * hi_bf(uu.x); y[2] = acc[2] + dsk.z * lo_bf(uu.y); y[3] = acc[3] + dsk.w * hi_bf(uu.y);
#pragma unroll
            for (int r = 0; r < 4; ++r) { const float a = 0.7978845608028654f * (y[r] + 0.044715f * y[r] * y[r] * y[r]); y[r] = y[r] * __builtin_amdgcn_rcpf(1.0f + __builtin_amdgcn_exp2f(-2.8853900817779268f * a)); }
            v2u o2; o2.x = pk2(y[0], y[1]); o2.y = pk2(y[2], y[3]);
            *(LAS v2u*)(y2 + tok * S2_Y2ROW + ch) = o2;
            asm volatile("s_waitcnt lgkmcnt(0)" ::: "memory");
          }
        }
    }
    __syncthreads();
    const int r32 = lane & 31, hi5 = lane >> 5;
    fa::f32x16 d0 = (fa::f32x16){}, d1 = (fa::f32x16){};
    const bf16* WT = (const bf16*)(F.ws() + WS_WGT) + (size_t)layer * 65536 + (size_t)(32 * w + r32) * 256;
#pragma unroll 4
    for (int ks = 0; ks < 16; ++ks) {
        const bf16x8 bw = *(const bf16x8*)(WT + 16 * ks + 8 * hi5);
        const bf16x8 a0 = *(const LAS bf16x8*)(y2 + r32 * S2_Y2ROW + 16 * ks + 8 * hi5), a1 = *(const LAS bf16x8*)(y2 + (32 + r32) * S2_Y2ROW + 16 * ks + 8 * hi5);
        d0 = __builtin_amdgcn_mfma_f32_32x32x16_bf16(a0, bw, d0, 0, 0, 0); d1 = __builtin_amdgcn_mfma_f32_32x32x16_bf16(a1, bw, d1, 0, 0, 0);
    }
    const int j = 32 * w + r32; const float bg = F.in[12][layer * 256 + j];
    float gate0[16], gate1[16];
#pragma unroll
    for (int r = 0; r < 16; ++r) { const int t = fa::crow(r, hi5);
        const float ya = bf2f(y2[t * S2_Y2ROW + j]), yb = bf2f(y2[(32 + t) * S2_Y2ROW + j]);
        gate0[r] = ya * __builtin_amdgcn_rcpf(1.0f + __builtin_amdgcn_exp2f(-1.4426950408889634f * (d0[r] + bg))); gate1[r] = yb * __builtin_amdgcn_rcpf(1.0f + __builtin_amdgcn_exp2f(-1.4426950408889634f * (d1[r] + bg))); }
    __syncthreads();
    LAS float* ost = (LAS float*)(F.lds + S2_OUT);
#pragma unroll
    for (int r = 0; r < 16; ++r) { const int t = fa::crow(r, hi5); ost[t * S2_OUTROW + j] = gate0[r]; ost[(32 + t) * S2_OUTROW + j] = gate1[r]; }
    __syncthreads();
    { const int tok = F.tid >> 3, c8 = F.tid & 7; bf16* dst = (bf16*)(F.ws() + WS_MIX) + (row0 + tok) * DM;
#pragma unroll
      for (int hd = 0; hd < 4; ++hd) {
          const f32x4 a = *(const LAS f32x4*)(ost + tok * S2_OUTROW + hd * 64 + c8 * 8), bq = *(const LAS f32x4*)(ost + tok * S2_OUTROW + hd * 64 + c8 * 8 + 4);
          float ss = (a.x * a.x + a.y * a.y) + (a.z * a.z + a.w * a.w) + (bq.x * bq.x + bq.y * bq.y) + (bq.z * bq.z + bq.w * bq.w);
          ss += shx(ss, 1, F.lane); ss += shx(ss, 2, F.lane); ss += shx(ss, 4, F.lane);
#if WOUT_I8
          const float rs = (127.0f / 8.0f) / sqrtf(ss * (1.0f / 64.0f) + EPS);
          v2u wv; wv.x = pack4_i8(a.x * rs, a.y * rs, a.z * rs, a.w * rs); wv.y = pack4_i8(bq.x * rs, bq.y * rs, bq.z * rs, bq.w * rs);
          *(v2u*)((unsigned char*)(F.ws() + WS_MIX) + (size_t)(row0 + tok) * DM + hd * 64 + c8 * 8) = wv; } }
#else
          const float rs = 1.0f / sqrtf(ss * (1.0f / 64.0f) + EPS);
          const float* gp = F.in[19] + layer * DM + hd * 64 + c8 * 8;
          v4u wv; wv.x = pk2(a.x * rs * gp[0], a.y * rs * gp[1]); wv.y = pk2(a.z * rs * gp[2], a.w * rs * gp[3]); wv.z = pk2(bq.x * rs * gp[4], bq.y * rs * gp[5]); wv.w = pk2(bq.z * rs * gp[6], bq.w * rs * gp[7]);
          *(v4u*)(dst + hd * 64 + c8 * 8) = wv; } }
#endif
}

constexpr int NS = 10, NSTEPS = 1 + DEPTH * NS + 1;
#ifndef PROBE
#define PROBE 0
#endif
#define NREP(x) ((PROBE == (x)) ? 2 : 1)
#define NREPG(k) ((PROBE == 1 || PROBE == (k)) ? 2 : 1)
#define DUMMY_OUT ((float*)(F.ws() + 704 * MiB))
#define IN(k) (lo <= (k) && (k) < hi)
#define REFRESH (refresh(F, lds0), true)
#define SEAM(k) do { if (IN(k) && IN((k) + 1)) xcd_barrier(lds0, F.wave0); } while (0)
#define SEAML(k, cond) do { if (IN(k) && IN((k) + 1)) { if ((cond) && F.MISC[12] != 0u) xcd_local_barrier(lds0, F.wave0); else xcd_barrier(lds0, F.wave0); } } while (0)
__device__ __forceinline__ void layer_body(Frame& F, const int layer, LAS unsigned char* const lds0, const int lo, const int hi) {
        const int s0 = 1 + layer * NS; const bool moe = (layer & 1) != 0; const int mi = layer >> 1;
        const float* xcur = (layer == 0) ? F.in[0] : nullptr;
        if (layer != 0) { for (int rep = 0; rep < ((layer != 2) ? NREP(21) : 1); ++rep) if (REFRESH && IN(s0)) { norm_phase(F, xcur, layer == 2, F.in[1] + layer * DM, false, nullptr, 0, true, WIN_I8 ? 2 : 0, WS_RSM); } SEAML(s0, true); }
#if WIN_I8
        for (int rep = 0; rep < NREPG(10); ++rep) if (REFRESH && IN(s0 + 1)) { pg8::Order S; S.init(NTOK / 256, INC / 256, F.G, F.bx, F.ws() + WS_H, F.ws() + WS_WIN + (size_t)layer * INC * DM, DM / 2, 0, nullptr);
            pg8::EpiProjI8 E{(bf16*)(F.ws() + WS_PROJ), INC, F.in[13] + layer * 64, F.in[14] + layer * 64, F.in[16] + layer * 64, F.in[17] + layer * 64, (const float*)(F.ws() + WS_RSM), (const float*)(F.ws() + WS_SWIN) + layer * INC};
            pg8::gemm_phase<pg8::EpiProjI8, 2>(F.lds, F.tid, DM / 2, S, E); } SEAML(s0 + 1, true);
#else
        for (int rep = 0; rep < NREPG(10); ++rep) if (REFRESH && IN(s0 + 1)) { pg8::Order S; S.init(NTOK / 256, INC / 256, F.G, F.bx, (const bf16*)(F.ws() + WS_H), (const bf16*)(F.ws() + WS_WIN) + (size_t)layer * INC * DM, DM, 0, nullptr);
            pg8::EpiProj E{(bf16*)(F.ws() + WS_PROJ), INC, F.in[13] + layer * 64, F.in[14] + layer * 64, F.in[16] + layer * 64, F.in[17] + layer * 64, nullptr, nullptr}; pg8::gemm_phase<pg8::EpiProj>(F.lds, F.tid, DM, S, E); } SEAM(s0 + 1);
#endif
        for (int rep = 0; rep < NREP(2); ++rep) if (REFRESH && IN(s0 + 3)) {
            for (int rep7 = 0; rep7 < NREP(3) + NREP(7) - 1; ++rep7) ssm_pass1(F, layer);
            refresh(F, lds0);
            const bool bal = (F.G == 256);
            int t_lo = 0, t_hi = 0;
            if (bal) { const int jb = F.vcu & 31; float sumdf = 0.f, mydf = 0.f, before = 0.f;
#define DF_COST(jj_) (2.06f * (float)(((jj_) & 1) ? ((64 - 4 * ((jj_) >> 1) < 33 ? 64 - 4 * ((jj_) >> 1) : 33) + 4) : ((64 - 4 * ((jj_) >> 1)) + (4 * ((jj_) >> 1) + 4 < 9 ? 4 * ((jj_) >> 1) + 4 : 9))) + 16.0f)
                for (int jj = 0; jj < 32; ++jj) sumdf += DF_COST(jj);
                const float ctot = 64.0f * 14.0f + 64.0f * 17.0f, T = (ctot + sumdf) * (1.0f / 32.0f);
                float sumb = 0.f;
                for (int jj = 0; jj < 32; ++jj) { const float bj = fmaxf(T - DF_COST(jj), 0.f); if (jj < jb) before += bj; if (jj == jb) mydf = bj; sumb += bj; }
                const float sc = ctot / sumb, lo_b = before * sc, hi_b = (before + mydf) * sc;
                float c = 0.f;
                for (int u = 0; u < 128; ++u) { const float co = u < 64 ? 14.0f : 17.0f, mid = c + 0.5f * co; if (mid <= lo_b) t_lo = u + 1; if (mid <= hi_b) t_hi = u + 1; c += co; }
                if (jb == 31) t_hi = 128;
#undef DF_COST
            }
            const int sb_lo = bal ? t_lo : F.vcu, sb_hi = bal ? (t_hi < 64 ? t_hi : 64) : 512, ch_lo = bal ? (t_lo > 64 ? t_lo : 64) : F.vcu, ch_hi = bal ? t_hi : 512, ust = bal ? 1 : F.G;
            for (int rep5 = 0; rep5 < NREP(5); ++rep5) for (int u = sb_lo; u < sb_hi; u += ust) { const int idx = bal ? u : (u & 31) + 32 * (u >> 8); fa::sb_unit(F, layer, bal ? (F.vcu >> 5) : ((u & 255) >> 5), idx >> 4, idx & 15); }
            refresh(F, lds0);
            for (int rep4 = 0; rep4 < NREP(4); ++rep4) for (int u = F.vcu; u < 512; u += F.G) { const int j = u & 31, i = u >> 8; fa::df_unit(F, layer, (u & 255) >> 5, (i == 0 ? 3 : 1) - (j & 1), (i == 0) ? 15 - (j >> 1) : (j >> 1)); }
            refresh(F, lds0);
            for (int rep6 = 0; rep6 < NREP(6); ++rep6) for (int u = ch_lo; u < ch_hi; u += ust) { const int idx = bal ? u - 64 : (u & 31) + 32 * (u >> 8); fa::ch_unit(F, layer, bal ? (F.vcu >> 5) : ((u & 255) >> 5), idx >> 4, idx & 15); }
            refresh(F, lds0);
            __syncthreads();
            moe_convert_half(F, layer >> 1, layer & 1);
#if DENSE_UP_I8
            if (layer == 0) dense_up_convert(F);
#endif
        } SEAML(s0 + 3, true);
        for (int rep = 0; rep < NREP(3); ++rep) if (REFRESH && IN(s0 + 4)) { for (int u = F.vcu; u < BATCH * 64; u += F.G) { const bool xb = (F.G == 256); ssm_pass2_unit(F, layer, xb ? ((u & 255) >> 5) : (u >> 6), xb ? ((u & 31) + 32 * (u >> 8)) : (u & 63)); } } SEAML(s0 + 4, layer != 0);
#if WOUT_I8
        for (int rep = NREPG(11) - 1; rep >= 0; --rep) if (REFRESH && IN(s0 + 5)) { pg8::Order S; S.init(NTOK / 256, DM / 256, F.G, F.bx, F.ws() + WS_MIX, F.ws() + WS_WOUT + (size_t)layer * DM * DM, DM / 2, 0, nullptr);
            pg8::EpiResBf16I8 E{xcur, (const bf16*)(F.ws() + WS_XRES), rep ? (bf16*)DUMMY_OUT : (bf16*)(F.ws() + WS_XRES), DM, 1.0f, (const float*)(F.ws() + WS_SWOUT) + layer * DM}; pg8::gemm_phase<pg8::EpiResBf16I8, 2>(F.lds, F.tid, DM / 2, S, E); } SEAML(s0 + 5, true);
#else
        for (int rep = NREPG(11) - 1; rep >= 0; --rep) if (REFRESH && IN(s0 + 5)) { pg8::Order S; S.init(NTOK / 256, DM / 256, F.G, F.bx, (const bf16*)(F.ws() + WS_MIX), (const bf16*)(F.ws() + WS_WOUT) + (size_t)layer * DM * DM, DM, 0, nullptr);
            pg8::EpiResBf16 E{xcur, (const bf16*)(F.ws() + WS_XRES), rep ? (bf16*)DUMMY_OUT : (bf16*)(F.ws() + WS_XRES), DM, 1.0f, nullptr}; pg8::gemm_phase<pg8::EpiResBf16>(F.lds, F.tid, DM, S, E); } SEAM(s0 + 5);
#endif
        for (int rep = 0; rep < (moe ? 1 : NREP(21)); ++rep) if (REFRESH && IN(s0 + 6)) { norm_phase(F, nullptr, false, F.in[21] + layer * DM, moe, F.in[25] + (size_t)mi * DM * NE, mi, true, moe ? (MOE_FP8 ? 1 : 0) : (DENSE_UP_I8 ? 2 : (DENSE_FP8 ? 1 : 0))); } SEAML(s0 + 6, !moe);
        if (!moe) {
#if DENSE_UP_I8
            for (int rep = 0; rep < NREPG(12); ++rep) if (REFRESH && IN(s0 + 7)) { pg8::Order S; S.init(NTOK / 256, 2 * DFF / 256, F.G, F.bx, F.ws() + WS_H, F.ws() + WS_WFUP + (size_t)mi * 2 * DFF * DM, DM / 2, 0, nullptr);
                const float ag = __uint_as_float(__hip_atomic_load((unsigned*)(F.ctl() + CW_AMAX + 64 * (2 * mi)), __ATOMIC_RELAXED, __HIP_MEMORY_SCOPE_AGENT)), au = __uint_as_float(__hip_atomic_load((unsigned*)(F.ctl() + CW_AMAX + 64 * (2 * mi + 1)), __ATOMIC_RELAXED, __HIP_MEMORY_SCOPE_AGENT));
                pg8::EpiSwiGLUI8 E{(bf16*)(F.ws() + WS_HID), DFF, (const float*)(F.ws() + WS_RS), ag * (1.0f / 127.0f), au * (1.0f / 127.0f)}; pg8::gemm_phase<pg8::EpiSwiGLUI8, 2>(F.lds, F.tid, DM / 2, S, E); } SEAML(s0 + 7, true);
            for (int rep = NREPG(13) - 1; rep >= 0; --rep) if (REFRESH && IN(s0 + 8)) { pg8::Order S; S.init(NTOK / 256, DM / 256, F.G, F.bx, (const bf16*)(F.ws() + WS_HID), (const bf16*)(F.ws() + WS_WFDN) + (size_t)mi * DM * DFF, DFF, 0, nullptr); S.rev = 1;
                pg8::EpiResBf16 E{nullptr, (const bf16*)(F.ws() + WS_XRES), rep ? (bf16*)DUMMY_OUT : (bf16*)(F.ws() + WS_XRES), DM, 1.0f, nullptr}; pg8::gemm_phase<pg8::EpiResBf16>(F.lds, F.tid, DFF, S, E); } SEAML(s0 + 8, true);
#elif DENSE_FP8
            for (int rep = 0; rep < NREPG(12); ++rep) if (REFRESH && IN(s0 + 7)) { pg8::Order S; S.init(NTOK / 256, 2 * DFF / 256, F.G, F.bx, F.ws() + WS_H, F.ws() + WS_WFUP + (size_t)mi * 2 * DFF * DM, DM / 2, 0, nullptr);
                pg8::EpiSwiGLU8 E{F.ws() + WS_HID, DFF, INV8}; pg8::gemm_phase<pg8::EpiSwiGLU8, true>(F.lds, F.tid, DM / 2, S, E); } SEAM(s0 + 7);
            for (int rep = NREPG(13) - 1; rep >= 0; --rep) if (REFRESH && IN(s0 + 8)) { pg8::Order S; S.init(NTOK / 256, DM / 256, F.G, F.bx, F.ws() + WS_HID, F.ws() + WS_WFDN + (size_t)mi * DM * DFF, DFF / 2, 0, nullptr);
                pg8::EpiResBf16 E{nullptr, (const bf16*)(F.ws() + WS_XRES), rep ? (bf16*)DUMMY_OUT : (bf16*)(F.ws() + WS_XRES), DM, INV8, nullptr}; pg8::gemm_phase<pg8::EpiResBf16, true>(F.lds, F.tid, DFF / 2, S, E); } SEAM(s0 + 8);
#else
            for (int rep = 0; rep < NREPG(12); ++rep) if (REFRESH && IN(s0 + 7)) { pg8::Order S; S.init(NTOK / 256, 2 * DFF / 256, F.G, F.bx, (const bf16*)(F.ws() + WS_H), (const bf16*)(F.ws() + WS_WFUP) + (size_t)mi * 2 * DFF * DM, DM, 0, nullptr);
                pg8::EpiSwiGLU E{(bf16*)(F.ws() + WS_HID), DFF}; pg8::gemm_phase<pg8::EpiSwiGLU>(F.lds, F.tid, DM, S, E); } SEAM(s0 + 7);
            for (int rep = NREPG(13) - 1; rep >= 0; --rep) if (REFRESH && IN(s0 + 8)) { pg8::Order S; S.init(NTOK / 256, DM / 256, F.G, F.bx, (const bf16*)(F.ws() + WS_HID), (const bf16*)(F.ws() + WS_WFDN) + (size_t)mi * DM * DFF, DFF, 0, nullptr); S.rev = 1;
                pg8::EpiResBf16 E{nullptr, (const bf16*)(F.ws() + WS_XRES), rep ? (bf16*)DUMMY_OUT : (bf16*)(F.ws() + WS_XRES), DM, 1.0f, nullptr}; pg8::gemm_phase<pg8::EpiResBf16>(F.lds, F.tid, DFF, S, E); } SEAM(s0 + 8);
#endif
        } else {
            if (REFRESH && IN(s0 + 7)) { moe_scatter(F, mi); } SEAM(s0 + 7);
#if MOE_FP8
            for (int rep = 0; rep < NREPG(14); ++rep) if (REFRESH && IN(s0 + 8)) { const int nT = moe_tile_table(F, mi);
                pg8::Order S; S.init(nT, 2 * DFE / 256, F.G, F.bx, F.ws() + WS_HPERM, F.ws() + WS_WMUP + (size_t)mi * WMUP_LAYER, DM / 2, (size_t)2 * DFE * DM, (const LAS int*)(F.lds + MISC_OFF + 32 * 4)); S.gmap = (const int*)(F.ws() + WS_SLOTTOK);
                pg8::EpiSwiGLU8 E{F.ws() + WS_HIDP, DFE, INV8}; pg8::gemm_phase<pg8::EpiSwiGLU8, 1, true, true>(F.lds, F.tid, DM / 2, S, E); } SEAM(s0 + 8);
            for (int rep = 0; rep < NREPG(15); ++rep) if (REFRESH && IN(s0 + 9)) { const int nT = moe_tile_table(F, mi);
                const int nunits = nT * (DM / 256), Gg = (layer == 1 && F.G == 256 && (hi - lo) > 1 && rep == 0) ? 8 * ((nunits + 39) / 40) : F.G;
                if (F.bx < Gg) {
                    pg8::Order S; S.init(nT, DM / 256, Gg, F.bx, F.ws() + WS_HIDP, F.ws() + WS_WMDN + (size_t)mi * WMDN_LAYER, DFE / 2, (size_t)DM * DFE, (const LAS int*)(F.lds + MISC_OFF + 32 * 4)); S.rev = 1;
                    pg8::EpiBf16 E{(bf16*)(F.ws() + WS_YPERM), DM, INV8}; pg8::gemm_phase<pg8::EpiBf16, true>(F.lds, F.tid, DFE / 2, S, E);
                } else { refresh(F, lds0); moe_convert_half(F, 1, 0); } } SEAM(s0 + 9);
#else
            for (int rep = 0; rep < NREPG(14); ++rep) if (REFRESH && IN(s0 + 8)) { const int nT = moe_tile_table(F, mi);
                pg8::Order S; S.init(nT, 2 * DFE / 256, F.G, F.bx, (const bf16*)(F.ws() + WS_HPERM), (const bf16*)(F.ws() + WS_WMUP), DM, (size_t)2 * DFE * DM * 2, (const LAS int*)(F.lds + MISC_OFF + 32 * 4));
                pg8::EpiSwiGLU E{(bf16*)(F.ws() + WS_HIDP), DFE}; pg8::gemm_phase<pg8::EpiSwiGLU>(F.lds, F.tid, DM, S, E); } SEAM(s0 + 8);
            for (int rep = 0; rep < NREPG(15); ++rep) if (REFRESH && IN(s0 + 9)) { const int nT = moe_tile_table(F, mi);
                pg8::Order S; S.init(nT, DM / 256, F.G, F.bx, (const bf16*)(F.ws() + WS_HIDP), (const bf16*)(F.ws() + WS_WMDN), DFE, (size_t)DM * DFE * 2, (const LAS int*)(F.lds + MISC_OFF + 32 * 4));
                pg8::EpiBf16 E{(bf16*)(F.ws() + WS_YPERM), DM, 1.0f}; pg8::gemm_phase<pg8::EpiBf16>(F.lds, F.tid, DFE, S, E); } SEAM(s0 + 9);
#endif
        }
    }

struct Args { const float* in[29]; float* out; unsigned char* ws; int step_lo, step_hi; };
__global__ void __launch_bounds__(NWAVES * 64, 2) hybrid_fwd(Args args) {
    extern __shared__ __attribute__((aligned(16))) unsigned char lds[];
    Frame F;
    LAS unsigned char* const lds0 = (LAS unsigned char*)lds;
    F.wave0 = __builtin_amdgcn_readfirstlane((int)threadIdx.x >> 6);
    refresh(F, lds0);
    for (int u = F.tid; u < (LDS_BYTES - LDSCTL_OFF) / 4; u += NWAVES * 64) ((LAS unsigned*)(F.lds + LDSCTL_OFF))[u] = 0u;
    __syncthreads();
    if (F.tid == 0) { LAS unsigned long long* pt = (LAS unsigned long long*)(F.lds + LDSCTL_OFF);
#pragma unroll
        for (int k = 0; k < 29; ++k) pt[k] = (unsigned long long)args.in[k];
        pt[29] = (unsigned long long)args.out; pt[30] = (unsigned long long)args.ws; }
    __syncthreads();
    const int lo = args.step_lo, hi = args.step_hi;
    const bool single = (hi - lo) > 1;
    if (single && F.tid == 0) __hip_atomic_fetch_or((unsigned*)(args.ws + WS_CTL) + CW_LG + 64 * (blockIdx.x % 8), 1u << xb_xcc_id(), __ATOMIC_RELAXED, __HIP_MEMORY_SCOPE_AGENT);
    if (single) (void)xcd_barrier_post((unsigned*)(args.ws + WS_CTL) + CW_BAR, (volatile LAS unsigned*)(lds0 + MISC_OFF) + 8);
    if (REFRESH && IN(0)) { prologue_convert(F); ssm_prep(F);
#if DENSE_UP_I8
        dense_amax(F);
#endif
#if WIN_I8
        win_amax(F);
#if WOUT_I8
        wout_amax(F);
#endif
        if (single) xcd_barrier(lds0, F.wave0);
        refresh(F, lds0);
        win_convert(F);
#if WOUT_I8
        wout_convert(F);
#endif
        norm_phase(F, F.in[0], false, F.in[1], false, nullptr, 0, true, 2, WS_RSM);
#else
        norm_phase(F, F.in[0], false, F.in[1], false, nullptr, 0, true, 0);
#endif
    } SEAM(0);
    if (single) { refresh(F, lds0);
        if (F.tid == 0) { unsigned all = 0u, ok = (F.G == 256) ? 1u : 0u;
            for (int g = 0; g < 8; ++g) { const unsigned m = __hip_atomic_load((unsigned*)(F.ctl() + CW_LG + 64 * g), __ATOMIC_RELAXED, __HIP_MEMORY_SCOPE_AGENT); if (m == 0u || (m & (m - 1u)) != 0u || (all & m) != 0u) ok = 0u; all |= m; }
            F.MISC[12] = ok; }
        __syncthreads(); }

    for (int layer = 0; layer < DEPTH; ++layer) layer_body(F, layer, lds0, lo, hi);
    for (int rep = 0; rep < NREP(21); ++rep) if (REFRESH && IN(NSTEPS - 1)) { norm_phase(F, nullptr, true, nullptr, false, nullptr, 0, false, 0); }
#undef IN
#undef SEAM
#undef REFRESH
}

extern "C" void kernel_launch(void* const* d_in, const int* in_sizes, int n_in, void* d_out, int out_size, void* d_ws, size_t ws_size, hipStream_t stream) {
    static int grid = 0;
    if (grid == 0) {
        if (n_in != 29 || out_size != NTOK * DM || ws_size < WS_END) { fprintf(stderr, "kernel_launch: unexpected problem (n_in %d, out %d, ws %zu)\n", n_in, out_size, ws_size); grid = -1; return; }
        int dev = 0, cus = 0, per_cu = 0;
        if (hipGetDevice(&dev) != hipSuccess || hipDeviceGetAttribute(&cus, hipDeviceAttributeMultiprocessorCount, dev) != hipSuccess) { grid = -1; return; }
        if (hipFuncSetAttribute((const void*)hybrid_fwd, hipFuncAttributeMaxDynamicSharedMemorySize, LDS_BYTES) != hipSuccess) { grid = -1; return; }
        if (hipOccupancyMaxActiveBlocksPerMultiprocessor(&per_cu, (const void*)hybrid_fwd, NWAVES * 64, LDS_BYTES) != hipSuccess || per_cu < 1) { fprintf(stderr, "kernel_launch: occupancy query says %d\n", per_cu); }
        (void)hipGetLastError();
        grid = cus;
    }
    if (grid < 0) return;
    Args a{};
    for (int i = 0; i < 29; ++i) a.in[i] = (const float*)d_in[i];
    a.out = (float*)d_out; a.ws = (unsigned char*)d_ws;
#ifdef MK_STEPWISE
    hipMemsetAsync((char*)d_ws + WS_CTL, 0, CTL_ZERO_BYTES, stream);
    for (int s = 0; s < NSTEPS; ++s) { a.step_lo = s; a.step_hi = s + 1; hipLaunchKernelGGL(hybrid_fwd, dim3(grid), dim3(NWAVES * 64), LDS_BYTES, stream, a); }
#else
    hipMemsetAsync((char*)d_ws + WS_CTL, 0, CTL_ZERO_BYTES, stream);
    a.step_lo = 0; a.step_hi = NSTEPS;
    hipLaunchKernelGGL(hybrid_fwd, dim3(grid), dim3(NWAVES * 64), LDS_BYTES, stream, a);
#endif
}
```

```cpp
#include <hip/hip_runtime.h>
#include <cstdio>
#include <cstdint>

#define GAS __attribute__((address_space(1)))
#define LAS __attribute__((address_space(3)))
typedef unsigned short bf16;
typedef unsigned v4u __attribute__((ext_vector_type(4)));
typedef unsigned v2u __attribute__((ext_vector_type(2)));
typedef float f32x4 __attribute__((ext_vector_type(4)));
typedef float f32x2 __attribute__((ext_vector_type(2)));
typedef short bf16x8 __attribute__((ext_vector_type(8)));
typedef GAS unsigned gu32;

#ifndef MOE_FP8
#define MOE_FP8 1
#endif
#ifndef DENSE_FP8
#define DENSE_FP8 0
#endif
#ifndef DENSE_UP_I8
#define DENSE_UP_I8 1
#ifndef DENSE_DN_FP8
#define DENSE_DN_FP8 1
#endif
#define WOUT_I8 1
#define WIN_I8 1
#endif
constexpr float ACT8 = 8.0f, WGT8 = 256.0f, INV8 = 1.0f / (ACT8 * WGT8);
constexpr int BATCH = 8, SEQ = 4096, DM = 1024, NTOK = BATCH * SEQ, DEPTH = 4;
constexpr int INC = 2560;
constexpr int C_U = 0, C_QSB = 256, C_KSB = 512, C_VSB = 768, C_QCH = 1024, C_KCH = 1280, C_VCH = 1536, C_QDF = 1792, C_KDF = 2048, C_VDF = 2304;
constexpr int DFF = 2816, NE = 8, DFE = 3584;
constexpr float EPS = 1e-6f;
constexpr int MOE_ROWS = 65536 + 8 * 256;

constexpr size_t MiB = 1u << 20;
constexpr size_t WS_CTL = 0, CTL_ZERO_BYTES = 1 * MiB;
constexpr size_t WS_WIN = 2 * MiB;
constexpr size_t WS_WOUT = 22 * MiB;
constexpr size_t WS_WFUP = 30 * MiB;
constexpr size_t WS_WFDN = 52 * MiB;
constexpr size_t WS_TOKINFO = 63 * MiB;
constexpr size_t WS_TOKSLOT = 63 * MiB + 512 * 1024;
constexpr size_t WS_SSMP = 1 * MiB;
constexpr size_t WS_SSMY = 64 * MiB;
constexpr size_t WMUP_LAYER = MOE_FP8 ? 56 * MiB : 0, WMDN_LAYER = MOE_FP8 ? 28 * MiB : 0;
constexpr size_t WS_WMUP = 96 * MiB;
constexpr size_t WS_WMDN = 208 * MiB;
constexpr size_t WS_PROJ = 264 * MiB;
constexpr size_t WS_MIX = 424 * MiB;
constexpr size_t WS_H = 488 * MiB;
constexpr size_t WS_HID = 264 * MiB;
constexpr size_t WS_HPERM = 264 * MiB;
constexpr size_t WS_YPERM = 264 * MiB;
constexpr size_t WS_HIDP = 396 * MiB;
constexpr size_t WS_SWIN = 12 * MiB + 256 * 1024;
constexpr size_t WS_SWOUT = 12 * MiB + 512 * 1024;
constexpr size_t WS_SLOTTOK = 13 * MiB;
constexpr size_t WS_RSM = 12 * MiB;
constexpr size_t WS_RS = 63 * MiB;
constexpr size_t WS_XRES = 640 * MiB;
constexpr size_t WS_END = 858 * MiB;
static_assert(WS_HIDP + (size_t)MOE_ROWS * DFE * 2 <= WS_END, "ws map");
static_assert(WS_HPERM + (size_t)MOE_ROWS * DM * 2 <= WS_HIDP, "ws map");

constexpr int CW_BAR = 4096;
constexpr int CW_CNT = 16384;
constexpr int CW_CUR = 16384 + 64 * 16;
constexpr int CW_AMAX = 16384 + 64 * 48;
constexpr int CW_DCQ = 16384 + 64 * 52;
constexpr int CW_LG = 16384 + 64 * 70;
constexpr int CW_CHMAXO = 65536 + 4 * 2560;
constexpr int CW_CHMAX = 65536;
constexpr int CW_CVQ = 16384 + 64 * 40;

constexpr int RING_BYTES = 131072;
constexpr int LDSCTL_OFF = RING_BYTES, MISC_OFF = LDSCTL_OFF + 320;
constexpr int LDS_BYTES = 147456;
constexpr int NWAVES = 8;

__device__ __forceinline__ float bf2f(unsigned short u) { return __uint_as_float((unsigned)u << 16); }
__device__ __forceinline__ unsigned f2bf(float f) { unsigned u = __float_as_uint(f); return (u + 0x7fffu + ((u >> 16) & 1u)) >> 16; }
__device__ __forceinline__ unsigned pk2(float lo, float hi) { typedef float f2_ __attribute__((ext_vector_type(2))); typedef __bf16 b2_ __attribute__((ext_vector_type(2))); f2_ v = {lo, hi}; b2_ b = __builtin_convertvector(v, b2_); return __builtin_bit_cast(unsigned, b); }
__device__ __forceinline__ float lo_bf(unsigned w) { return __uint_as_float(w << 16); }
__device__ __forceinline__ float hi_bf(unsigned w) { return __uint_as_float(w & 0xffff0000u); }
#define LDS_WAIT() asm volatile("s_waitcnt lgkmcnt(0)" ::: "memory")
#define VM_WAIT() asm volatile("s_waitcnt vmcnt(0)" ::: "memory")

__device__ __forceinline__ unsigned pack4_fp8(float a, float b, float c, float d) {
    a = __builtin_amdgcn_fmed3f(a, -448.f, 448.f); b = __builtin_amdgcn_fmed3f(b, -448.f, 448.f); c = __builtin_amdgcn_fmed3f(c, -448.f, 448.f); d = __builtin_amdgcn_fmed3f(d, -448.f, 448.f);
    int r = __builtin_amdgcn_cvt_pk_fp8_f32(a, b, 0, false); r = __builtin_amdgcn_cvt_pk_fp8_f32(c, d, r, true); return (unsigned)r;
}
__device__ __forceinline__ unsigned pack4_i8(float a, float b, float c, float d) {
    const int ia = (int)__builtin_amdgcn_fmed3f(rintf(a), -127.f, 127.f), ib = (int)__builtin_amdgcn_fmed3f(rintf(b), -127.f, 127.f), ic = (int)__builtin_amdgcn_fmed3f(rintf(c), -127.f, 127.f), id = (int)__builtin_amdgcn_fmed3f(rintf(d), -127.f, 127.f);
    return ((unsigned)ia & 0xffu) | (((unsigned)ib & 0xffu) << 8) | (((unsigned)ic & 0xffu) << 16) | ((unsigned)id << 24);
}
namespace pg8 {
#define PG8_LAS __attribute__((address_space(3)))
typedef unsigned short bf16_t;
typedef unsigned u32x4 __attribute__((ext_vector_type(4)));
typedef int v4i_t __attribute__((ext_vector_type(4)));
typedef int v8i_t __attribute__((ext_vector_type(8)));
constexpr int BM = 256, BK = 64, HALF = 128, HTB = HALF * BK * 2, STAGE_BYTES = 8 * HTB, NXCD = 8, WGM = 8;

__host__ __device__ __forceinline__ int lds_byte(int r, int c) { const int st = (r >> 4) * 2 + (c >> 5), rr = r & 15, cc = c & 31, ob = rr * 64 + cc * 2; return st * 1024 + (ob ^ (((ob >> 9) & 1) << 5)); }
__host__ __device__ __forceinline__ void stage_rc(int b, int& R, int& C) { const int st = b / 1024, sb = b % 1024, swz = sb ^ (((sb >> 9) & 1) << 5); R = (st >> 1) * 16 + swz / 64; C = (st & 1) * 32 + (swz % 64) / 2; }
__host__ __device__ __forceinline__ int perm32(int rho) { const int n = rho >> 4, i = rho & 15; return 8 * (i >> 2) + 4 * n + (i & 3); }

struct Unit { int pm, pn; const char* A; const char* B; };

struct Order {
    int nM, nN, nwg, G, c, rev; const char* A; const char* Bt; size_t tstep; size_t estride; const LAS int* tstart; const int* gmap = nullptr;
    __device__ __forceinline__ void init(int nM_, int nN_, int G_, int c_, const void* A_, const void* Bt_, int K, size_t estride_, const LAS int* tstart_) {
        nM = nM_; nN = nN_; nwg = nM * nN; G = G_; c = c_; rev = 0; A = (const char*)A_; Bt = (const char*)Bt_; tstep = (size_t)BM * K * 2; estride = estride_; tstart = tstart_; }
    __device__ __forceinline__ bool next(int i, Unit& u) const {
        const long L = (long)i * G + c; if (L >= nwg) return false;
        int wgid = (int)L; { const int q = nwg / NXCD, r = nwg % NXCD, xcd = wgid % NXCD, len = q + (xcd < r ? 1 : 0); int off = wgid / NXCD; if (rev) off = len - 1 - off;
          wgid = (xcd < r ? xcd * (q + 1) : r * (q + 1) + (xcd - r) * q) + off; }
        const int nig = WGM * nN, gid = wgid / nig, fm = gid * WGM, gsz = (nM - fm) < WGM ? (nM - fm) : WGM;
        u.pm = fm + ((wgid % nig) % gsz); u.pn = (wgid % nig) / gsz;
        int e = 0;
        if (tstart) {
#pragma unroll
            for (int k = 1; k < 8; ++k) e += (u.pm >= tstart[k]) ? 1 : 0;
        }
        e = __builtin_amdgcn_readfirstlane(e);
        u.A = A + (size_t)u.pm * tstep; u.B = Bt + (size_t)e * estride + (size_t)u.pn * tstep; return true;
    }
};

__device__ __forceinline__ unsigned cvt_pk_bf16(float lo, float hi) { unsigned r; asm volatile("v_cvt_pk_bf16_f32 %0, %1, %2" : "=v"(r) : "v"(lo), "v"(hi)); return r; }

struct EpiBf16 {
    static constexpr bool PERM = true;
    bf16_t* O; int ldc; float sc;
    __device__ __forceinline__ void operator()(const f32x4 (&acc)[2][2][4][2], const Unit& u, int wr, int wc, int fr, int fq) const {
        const int row0 = u.pm * BM + wr * 64 + fr; const int col0 = u.pn * BM + wc * 32 + 8 * fq;
#pragma unroll
        for (int ai = 0; ai < 2; ++ai)
#pragma unroll
            for (int m = 0; m < 4; ++m) { bf16_t* rowp = O + (size_t)(row0 + ai * HALF + m * 16) * ldc + col0;
#pragma unroll
                for (int bj = 0; bj < 2; ++bj) { const f32x4 v0 = acc[ai][bj][m][0] * sc, v1 = acc[ai][bj][m][1] * sc;
                    u32x4 w; w.x = cvt_pk_bf16(v0[0], v0[1]); w.y = cvt_pk_bf16(v0[2], v0[3]); w.z = cvt_pk_bf16(v1[0], v1[1]); w.w = cvt_pk_bf16(v1[2], v1[3]);
                    *(u32x4*)(rowp + bj * HALF) = w; } }
    }
};
__device__ __forceinline__ float epi_sum4(float v) {
    { auto q = __builtin_amdgcn_permlane16_swap(__float_as_uint(v), __float_as_uint(v), false, false); v = __uint_as_float(q[0]) + __uint_as_float(q[1]); }
    { auto q = __builtin_amdgcn_permlane32_swap(__float_as_uint(v), __float_as_uint(v), false, false); v = __uint_as_float(q[0]) + __uint_as_float(q[1]); }
    return v;
}
__device__ __forceinline__ float epi_shx(float v, int m, int lane) { return __int_as_float(__builtin_amdgcn_ds_bpermute((lane ^ m) << 2, __float_as_int(v))); }
template <bool I8>
struct EpiProjT {
    static constexpr bool PERM = true;
    bf16_t* O; int ldc; const float* gqc; const float* gkc; const float* gqd; const float* gkd; const float* rs; const float* sw;
    __device__ __forceinline__ void operator()(const f32x4 (&acc)[2][2][4][2], const Unit& u, int wr, int wc, int fr, int fq) const {
        const int row0 = u.pm * BM + wr * 64 + fr; const int col0 = u.pn * BM + wc * 32 + 8 * fq; const int lane = fr + 16 * fq;
        const int mode = (u.pn == 4 || u.pn == 5) ? 1 : ((u.pn == 7 || u.pn == 8) ? 2 : 0);
        float g[2][8];
#pragma unroll
        for (int bj = 0; bj < 2; ++bj)
#pragma unroll
            for (int e = 0; e < 8; ++e) g[bj][e] = 1.0f;
        if (mode == 1) { const float* gp = (u.pn == 4) ? gqc : gkc;
#pragma unroll
            for (int bj = 0; bj < 2; ++bj)
#pragma unroll
                for (int e = 0; e < 8; ++e) g[bj][e] = gp[bj * 32 + 8 * fq + e]; }
        else if (mode == 2) { const float* gp = ((u.pn == 7) ? gqd : gkd) + (wc & 1) * 32 + 8 * fq;
#pragma unroll
            for (int e = 0; e < 8; ++e) { g[0][e] = gp[e]; g[1][e] = gp[e]; } }
        float swv[2][8];
        float r8[2][4] = {{1.f, 1.f, 1.f, 1.f}, {1.f, 1.f, 1.f, 1.f}};
        if constexpr (I8) {
#pragma unroll
            for (int bj = 0; bj < 2; ++bj)
#pragma unroll
                for (int e = 0; e < 8; ++e) swv[bj][e] = sw[col0 + bj * HALF + e];
#pragma unroll
            for (int ai = 0; ai < 2; ++ai)
#pragma unroll
                for (int m = 0; m < 4; ++m) r8[ai][m] = rs[row0 + ai * HALF + m * 16];
            asm volatile("" : "+v"(r8[0][0]), "+v"(r8[0][1]), "+v"(r8[0][2]), "+v"(r8[0][3]), "+v"(r8[1][0]), "+v"(r8[1][1]), "+v"(r8[1][2]), "+v"(r8[1][3])); }
#pragma unroll
        for (int ai = 0; ai < 2; ++ai)
#pragma unroll
            for (int m = 0; m < 4; ++m) { bf16_t* rowp = O + (size_t)(row0 + ai * HALF + m * 16) * ldc + col0;
                f32x4 v[2][2];
                if constexpr (I8) { const float r = r8[ai][m];
#pragma unroll
                    for (int bj = 0; bj < 2; ++bj)
#pragma unroll
                        for (int n = 0; n < 2; ++n) { const v4i_t t = __builtin_bit_cast(v4i_t, acc[ai][bj][m][n]);
                            v[bj][n] = (f32x4){(float)t[0] * (r * swv[bj][4 * n]), (float)t[1] * (r * swv[bj][4 * n + 1]), (float)t[2] * (r * swv[bj][4 * n + 2]), (float)t[3] * (r * swv[bj][4 * n + 3])}; }
                } else {
#pragma unroll
                    for (int bj = 0; bj < 2; ++bj) { v[bj][0] = acc[ai][bj][m][0]; v[bj][1] = acc[ai][bj][m][1]; } }
                if (mode != 0) {
                    float s0 = 0.f, s1 = 0.f;
#pragma unroll
                    for (int n = 0; n < 2; ++n)
#pragma unroll
                        for (int j = 0; j < 4; ++j) { s0 += v[0][n][j] * v[0][n][j]; s1 += v[1][n][j] * v[1][n][j]; }
                    s0 = epi_sum4(s0); s1 = epi_sum4(s1);
                    float r0, r1;
                    if (mode == 1) { r0 = __builtin_amdgcn_rsqf((s0 + s1) * (1.0f / 64.0f) + 1e-6f); r1 = r0; }
                    else { r0 = __builtin_amdgcn_rsqf(s0 * (1.0f / 32.0f) + 1e-6f); r1 = __builtin_amdgcn_rsqf(s1 * (1.0f / 32.0f) + 1e-6f); }
#pragma unroll
                    for (int n = 0; n < 2; ++n)
#pragma unroll
                        for (int j = 0; j < 4; ++j) { v[0][n][j] *= r0 * g[0][4 * n + j]; v[1][n][j] *= r1 * g[1][4 * n + j]; }
                }
#pragma unroll
                for (int bj = 0; bj < 2; ++bj) { const f32x4 v0 = v[bj][0], v1 = v[bj][1];
                    u32x4 w; w.x = cvt_pk_bf16(v0[0], v0[1]); w.y = cvt_pk_bf16(v0[2], v0[3]); w.z = cvt_pk_bf16(v1[0], v1[1]); w.w = cvt_pk_bf16(v1[2], v1[3]);
                    *(u32x4*)(rowp + bj * HALF) = w; } }
    }
};
typedef EpiProjT<false> EpiProj; typedef EpiProjT<true> EpiProjI8;
__device__ __forceinline__ float silu_mul(float g, float u) { return g * __builtin_amdgcn_rcpf(1.0f + __builtin_amdgcn_exp2f(-1.4426950408889634f * g)) * u; }
struct EpiSwiGLU {
    static constexpr bool PERM = true;
    bf16_t* O; int ldc;
    __device__ __forceinline__ void operator()(const f32x4 (&acc)[2][2][4][2], const Unit& u, int wr, int wc, int fr, int fq) const {
        const int row0 = u.pm * BM + wr * 64 + fr; const int col0 = u.pn * HALF + wc * 32 + 8 * fq;
#pragma unroll
        for (int ai = 0; ai < 2; ++ai)
#pragma unroll
            for (int m = 0; m < 4; ++m) { bf16_t* rowp = O + (size_t)(row0 + ai * HALF + m * 16) * ldc + col0;
                const f32x4 g0 = acc[ai][0][m][0], g1 = acc[ai][0][m][1], u0 = acc[ai][1][m][0], u1 = acc[ai][1][m][1];
                u32x4 w; w.x = cvt_pk_bf16(silu_mul(g0[0], u0[0]), silu_mul(g0[1], u0[1])); w.y = cvt_pk_bf16(silu_mul(g0[2], u0[2]), silu_mul(g0[3], u0[3]));
                w.z = cvt_pk_bf16(silu_mul(g1[0], u1[0]), silu_mul(g1[1], u1[1])); w.w = cvt_pk_bf16(silu_mul(g1[2], u1[2]), silu_mul(g1[3], u1[3]));
                *(u32x4*)rowp = w; }
    }
};
__device__ __forceinline__ void swiglu_batch8_fold(const float (&a)[8], const float (&b)[8], float k1, float ik2, float (&o)[8]) {
    float t[8];
#pragma unroll
    for (int j = 0; j < 8; ++j) { t[j] = k1 * a[j]; o[j] = a[j] * b[j]; asm volatile("" : "+v"(o[j])); }
    __builtin_amdgcn_sched_barrier(0);
#pragma unroll
    for (int j = 0; j < 8; ++j) t[j] = __builtin_amdgcn_exp2f(t[j]);
    __builtin_amdgcn_sched_barrier(0);
#pragma unroll
    for (int j = 0; j < 8; ++j) t[j] = __builtin_fmaf(t[j], ik2, ik2);
    __builtin_amdgcn_sched_barrier(0);
#pragma unroll
    for (int j = 0; j < 8; ++j) t[j] = __builtin_amdgcn_rcpf(t[j]);
    __builtin_amdgcn_sched_barrier(0);
#pragma unroll
    for (int j = 0; j < 8; ++j) o[j] *= t[j];
    __builtin_amdgcn_sched_barrier(0);
}
__device__ __forceinline__ void swiglu_batch8(const float (&a)[8], const float (&b)[8], float k1, float k2, float (&o)[8]) {
    float t[8];
#pragma unroll
    for (int j = 0; j < 8; ++j) { t[j] = k1 * a[j]; o[j] = a[j] * b[j]; asm volatile("" : "+v"(o[j])); }
    __builtin_amdgcn_sched_barrier(0);
#pragma unroll
    for (int j = 0; j < 8; ++j) t[j] = __builtin_amdgcn_exp2f(t[j]);
    __builtin_amdgcn_sched_barrier(0);
#pragma unroll
    for (int j = 0; j < 8; ++j) t[j] = 1.0f + t[j];
    __builtin_amdgcn_sched_barrier(0);
#pragma unroll
    for (int j = 0; j < 8; ++j) t[j] = __builtin_amdgcn_rcpf(t[j]);
    __builtin_amdgcn_sched_barrier(0);
#pragma unroll
    for (int j = 0; j < 8; ++j) o[j] *= k2 * t[j];
    __builtin_amdgcn_sched_barrier(0);
}
struct EpiSwiGLU8 {
    static constexpr bool PERM = true;
    unsigned char* O; int ldc; float sc;
    __device__ __forceinline__ void operator()(const f32x4 (&acc)[2][2][4][2], const Unit& u, int wr, int wc, int fr, int fq) const {
        const int row0 = u.pm * BM + wr * 64 + fr; const int col0 = u.pn * HALF + wc * 32 + 8 * fq;
#pragma unroll
        for (int ai = 0; ai < 2; ++ai)
#pragma unroll
            for (int m = 0; m < 4; ++m) { unsigned char* rowp = O + (size_t)(row0 + ai * HALF + m * 16) * ldc + col0;
                const f32x4 a0 = acc[ai][0][m][0], a1 = acc[ai][0][m][1], b0 = acc[ai][1][m][0], b1 = acc[ai][1][m][1];
                const float k1 = -1.4426950408889634f * sc, ik2 = 1.0f / (8.0f * sc * sc);
                const float av[8] = {a0[0], a0[1], a0[2], a0[3], a1[0], a1[1], a1[2], a1[3]}, bv[8] = {b0[0], b0[1], b0[2], b0[3], b1[0], b1[1], b1[2], b1[3]}; float ov[8];
                swiglu_batch8_fold(av, bv, k1, ik2, ov);
                typedef unsigned u32x2 __attribute__((ext_vector_type(2))); u32x2 w;
                w.x = pack4_fp8(ov[0], ov[1], ov[2], ov[3]); w.y = pack4_fp8(ov[4], ov[5], ov[6], ov[7]);
                *(u32x2*)rowp = w; }
    }
};
template <bool F8OUT>
struct EpiSwiGLUI8T {
    static constexpr bool PERM = true;
    bf16_t* O; int ldc; const float* rs; float sg, su;
    __device__ __forceinline__ void operator()(const f32x4 (&acc)[2][2][4][2], const Unit& u, int wr, int wc, int fr, int fq) const {
        const int row0 = u.pm * BM + wr * 64 + fr; const int col0 = u.pn * HALF + wc * 32 + 8 * fq;
        float r8[2][4];
#pragma unroll
        for (int ai = 0; ai < 2; ++ai)
#pragma unroll
            for (int m = 0; m < 4; ++m) r8[ai][m] = rs[row0 + ai * HALF + m * 16];
        asm volatile("" : "+v"(r8[0][0]), "+v"(r8[0][1]), "+v"(r8[0][2]), "+v"(r8[0][3]), "+v"(r8[1][0]), "+v"(r8[1][1]), "+v"(r8[1][2]), "+v"(r8[1][3]));
#pragma unroll
        for (int ai = 0; ai < 2; ++ai)
#pragma unroll
            for (int m = 0; m < 4; ++m) { const int row = row0 + ai * HALF + m * 16; bf16_t* rowp = F8OUT ? (bf16_t*)((unsigned char*)O + (size_t)row * ldc + col0) : O + (size_t)row * ldc + col0;
                const float r = r8[ai][m], rg = r * sg, ru = r * su, k1 = -1.4426950408889634f * rg, k2 = rg * ru;
                const v4i_t g0 = __builtin_bit_cast(v4i_t, acc[ai][0][m][0]), g1 = __builtin_bit_cast(v4i_t, acc[ai][0][m][1]), u0 = __builtin_bit_cast(v4i_t, acc[ai][1][m][0]), u1 = __builtin_bit_cast(v4i_t, acc[ai][1][m][1]);
#define SGI(a_, b_) (((float)(a_) * (float)(b_)) * (k2 * __builtin_amdgcn_rcpf(1.0f + __builtin_amdgcn_exp2f(k1 * (float)(a_)))))
                if constexpr (F8OUT) { typedef unsigned u32x2 __attribute__((ext_vector_type(2))); u32x2 w8; const float k2s = k2; (void)k2s;
                    const float av[8] = {(float)g0[0], (float)g0[1], (float)g0[2], (float)g0[3], (float)g1[0], (float)g1[1], (float)g1[2], (float)g1[3]};
                    const float bv[8] = {(float)u0[0], (float)u0[1], (float)u0[2], (float)u0[3], (float)u1[0], (float)u1[1], (float)u1[2], (float)u1[3]}; float ov[8];
                    swiglu_batch8(av, bv, k1, 8.0f * k2, ov);
                    w8.x = pack4_fp8(ov[0], ov[1], ov[2], ov[3]); w8.y = pack4_fp8(ov[4], ov[5], ov[6], ov[7]); *(u32x2*)rowp = w8;
                } else { u32x4 w; w.x = cvt_pk_bf16(SGI(g0[0], u0[0]), SGI(g0[1], u0[1])); w.y = cvt_pk_bf16(SGI(g0[2], u0[2]), SGI(g0[3], u0[3]));
                    w.z = cvt_pk_bf16(SGI(g1[0], u1[0]), SGI(g1[1], u1[1])); w.w = cvt_pk_bf16(SGI(g1[2], u1[2]), SGI(g1[3], u1[3])); *(u32x4*)rowp = w; } }
#undef SGI
    }
};
typedef EpiSwiGLUI8T<false> EpiSwiGLUI8; typedef EpiSwiGLUI8T<true> EpiSwiGLUI8F8;
struct EpiF32Res {
    static constexpr bool PERM = false;
    const float* res; float* out; int ldc; float sc;
    __device__ __forceinline__ void operator()(const f32x4 (&acc)[2][2][4][2], const Unit& u, int wr, int wc, int fr, int fq) const {
        const int row0 = u.pm * BM + wr * 64 + fr, col0 = u.pn * BM + wc * 32 + 4 * fq;
#pragma unroll
        for (int ai = 0; ai < 2; ++ai)
#pragma unroll
            for (int m = 0; m < 4; ++m) { const size_t off = (size_t)(row0 + ai * HALF + m * 16) * ldc + col0;
                f32x4 r[2][2];
#pragma unroll
                for (int bj = 0; bj < 2; ++bj)
#pragma unroll
                    for (int n = 0; n < 2; ++n) r[bj][n] = *(const f32x4*)(res + off + bj * HALF + n * 16);
#pragma unroll
                for (int bj = 0; bj < 2; ++bj)
#pragma unroll
                    for (int n = 0; n < 2; ++n) *(f32x4*)(out + off + bj * HALF + n * 16) = r[bj][n] + acc[ai][bj][m][n] * sc; }
    }
};

template <bool I8>
struct EpiResBf16T {
    static constexpr bool PERM = true;
    const float* res32; const bf16_t* res16; bf16_t* out; int ldc; float sc; const float* sw;
    __device__ __forceinline__ f32x4 val(const f32x4& a, const float* s4) const {
        if constexpr (I8) { const v4i_t t = __builtin_bit_cast(v4i_t, a); return (f32x4){(float)t[0] * s4[0], (float)t[1] * s4[1], (float)t[2] * s4[2], (float)t[3] * s4[3]}; }
        else return a * sc; }
    __device__ __forceinline__ void operator()(const f32x4 (&acc)[2][2][4][2], const Unit& u, int wr, int wc, int fr, int fq) const {
        const int row0 = u.pm * BM + wr * 64 + fr; const int col0 = u.pn * BM + wc * 32 + 8 * fq;
        float swv[2][8];
#pragma unroll
        for (int bj = 0; bj < 2; ++bj)
#pragma unroll
            for (int e = 0; e < 8; ++e) swv[bj][e] = I8 ? sw[col0 + bj * HALF + e] : 0.f;
        if (res32) {
#pragma unroll
            for (int ai = 0; ai < 2; ++ai)
#pragma unroll
                for (int m = 0; m < 4; ++m) { const size_t off = (size_t)(row0 + ai * HALF + m * 16) * ldc + col0;
                    f32x4 r[2][2];
#pragma unroll
                    for (int bj = 0; bj < 2; ++bj) { r[bj][0] = *(const f32x4*)(res32 + off + bj * HALF); r[bj][1] = *(const f32x4*)(res32 + off + bj * HALF + 4); }
#pragma unroll
                    for (int bj = 0; bj < 2; ++bj) { const f32x4 v0 = r[bj][0] + val(acc[ai][bj][m][0], swv[bj]), v1 = r[bj][1] + val(acc[ai][bj][m][1], swv[bj] + 4);
                        u32x4 w; w.x = cvt_pk_bf16(v0[0], v0[1]); w.y = cvt_pk_bf16(v0[2], v0[3]); w.z = cvt_pk_bf16(v1[0], v1[1]); w.w = cvt_pk_bf16(v1[2], v1[3]);
                        *(u32x4*)(out + off + bj * HALF) = w; } }
        } else {
            constexpr int NH = I8 ? 1 : 2;
#pragma unroll
            for (int a0 = 0; a0 < 2; a0 += NH) {
            u32x4 q[NH][4][2];
#pragma unroll
            for (int ai = 0; ai < NH; ++ai)
#pragma unroll
                for (int m = 0; m < 4; ++m)
#pragma unroll
                    for (int bj = 0; bj < 2; ++bj) q[ai][m][bj] = *(const u32x4*)(res16 + (size_t)(row0 + (a0 + ai) * HALF + m * 16) * ldc + col0 + bj * HALF);
            asm volatile("" ::: "memory");
#pragma unroll
            for (int ai = 0; ai < NH; ++ai)
#pragma unroll
                for (int m = 0; m < 4; ++m)
#pragma unroll
                    for (int bj = 0; bj < 2; ++bj) { const u32x4 t = q[ai][m][bj];
                        const f32x4 r0 = (f32x4){__uint_as_float(t.x << 16), __uint_as_float(t.x & 0xffff0000u), __uint_as_float(t.y << 16), __uint_as_float(t.y & 0xffff0000u)};
                        const f32x4 r1 = (f32x4){__uint_as_float(t.z << 16), __uint_as_float(t.z & 0xffff0000u), __uint_as_float(t.w << 16), __uint_as_float(t.w & 0xffff0000u)};
                        const f32x4 v0 = r0 + val(acc[a0 + ai][bj][m][0], swv[bj]), v1 = r1 + val(acc[a0 + ai][bj][m][1], swv[bj] + 4);
                        u32x4 w; w.x = cvt_pk_bf16(v0[0], v0[1]); w.y = cvt_pk_bf16(v0[2], v0[3]); w.z = cvt_pk_bf16(v1[0], v1[1]); w.w = cvt_pk_bf16(v1[2], v1[3]);
                        *(u32x4*)(out + (size_t)(row0 + (a0 + ai) * HALF + m * 16) * ldc + col0 + bj * HALF) = w; }
            asm volatile("" ::: "memory");
            }
        }
    }
};
typedef EpiResBf16T<false> EpiResBf16; typedef EpiResBf16T<true> EpiResBf16I8;
template <class Epi, int MODE = 0  , bool ALIGN_EPI = true, bool GATHER = false>
__device__ __forceinline__ void gemm_phase(PG8_LAS unsigned char* lds, const int tid, const int K, const Order& S, const Epi& E) {
    const int wid = __builtin_amdgcn_readfirstlane(tid >> 6), lane = tid & 63, wr = wid >> 2, wc = wid & 3, fr = lane & 15, fq = lane >> 4;
    const int nt = K / BK;
    unsigned voffA[2], voffB[2];
#pragma unroll
    for (int i = 0; i < 2; ++i) { int R, C; stage_rc(tid * 16 + i * 8192, R, C); const int Rb = Epi::PERM ? ((R & ~31) + perm32(R & 31)) : R;
        voffA[i] = (unsigned)(R * K + C) * 2u; voffB[i] = (unsigned)(Rb * K + C) * 2u; }
    const size_t kstep = (size_t)(BK * 2);
    const size_t hstep = (size_t)HALF * K * 2;
    const unsigned ldsw = (unsigned)wid * 1024u;
    const int aoff = lds_byte(wr * 64 + fr, fq * 8), boff = lds_byte(wc * 32 + fr, fq * 8);
    unsigned baseA[2][2], baseB[2][2];
#pragma unroll
    for (int b_ = 0; b_ < 2; ++b_)
#pragma unroll
        for (int h_ = 0; h_ < 2; ++h_) { baseA[b_][h_] = (unsigned)(unsigned long long)lds + (unsigned)(((b_ * 2 + h_) * HTB) + aoff); baseB[b_][h_] = (unsigned)(unsigned long long)lds + (unsigned)(((4 + b_ * 2 + h_) * HTB) + boff);
            asm volatile("" : "+v"(baseA[b_][h_]), "+v"(baseB[b_][h_])); }
#define PG8_SA(b, h) (((b) * 2 + (h)) * HTB)
#define PG8_SB(b, h) ((4 + (b) * 2 + (h)) * HTB)
#define PG8_STAGE(bufoff, gbase, voff) do { _Pragma("unroll") for (int _i = 0; _i < 2; ++_i) \
        __builtin_amdgcn_global_load_lds((const unsigned*)((const char*)(gbase) + (voff)[_i]), (PG8_LAS unsigned*)(lds + (bufoff) + ldsw + _i * 8192), 16, 0, 0); } while (0)
    unsigned vgc[2][2] = {{0u, 0u}, {0u, 0u}}, vgn[2][2] = {{0u, 0u}, {0u, 0u}};
#define PG8_GLOAD(dst, pm_) do { _Pragma("unroll") for (int h_ = 0; h_ < 2; ++h_) _Pragma("unroll") for (int i_ = 0; i_ < 2; ++i_) { int R_, C_; stage_rc(tid * 16 + i_ * 8192, R_, C_); \
        dst[h_][i_] = (unsigned)S.gmap[(pm_) * BM + h_ * HALF + R_] * (unsigned)(K * 2) + (unsigned)C_ * 2u; } } while (0)
#define PG8_STAGE_A(bufoff, h, kb, nx) do { if constexpr (GATHER) { _Pragma("unroll") for (int _i = 0; _i < 2; ++_i) \
            __builtin_amdgcn_global_load_lds((const unsigned*)(S.A + (kb) + ((nx) ? vgn[h][_i] : vgc[h][_i])), (PG8_LAS unsigned*)(lds + (bufoff) + ldsw + _i * 8192), 16, 0, 0); } \
        else PG8_STAGE(bufoff, ((nx) ? nA : cA) + ((h) ? hstep : 0) + (kb), voffA); } while (0)
#define PG8_RD(base, off) (*(const PG8_LAS v4i_t*)((PG8_LAS unsigned char*)(base) + (off)))
#define PG8_LDA(dst, b, h) do { _Pragma("unroll") for (int m = 0; m < 4; ++m) { const v4i_t x0_ = PG8_RD(baseA[b][h], m * 2048), x1_ = PG8_RD(baseA[b][h], m * 2048 + 1024); \
        dst[m] = __builtin_shufflevector(x0_, x1_, 0, 1, 2, 3, 4, 5, 6, 7); } } while (0)
#define PG8_LDB(dst, b, h) do { _Pragma("unroll") for (int n = 0; n < 2; ++n) { const v4i_t x0_ = PG8_RD(baseB[b][h], n * 2048), x1_ = PG8_RD(baseB[b][h], n * 2048 + 1024); \
        dst[n] = __builtin_shufflevector(x0_, x1_, 0, 1, 2, 3, 4, 5, 6, 7); } } while (0)
#define PG8_LO(x) __builtin_bit_cast(bf16x8, __builtin_shufflevector(x, x, 0, 1, 2, 3))
#define PG8_HI(x) __builtin_bit_cast(bf16x8, __builtin_shufflevector(x, x, 4, 5, 6, 7))
#define PG8_MMA(ai, bj, At, Bt, Z) do { __builtin_amdgcn_s_setprio(1); _Pragma("unroll") for (int m = 0; m < 4; ++m) _Pragma("unroll") for (int n = 0; n < 2; ++n) { \
        if constexpr (Z) {   \
            if constexpr (MODE == 1) { asm volatile("v_mfma_f32_16x16x128_f8f6f4 %0, %1, %2, 0" : "=&v"(acc[ai][bj][m][n]) : "v"(Bt[n]), "v"(At[m])); } \
            else if constexpr (MODE == 2) { const v4i_t b0_ = __builtin_shufflevector(Bt[n], Bt[n], 0, 1, 2, 3), b1_ = __builtin_shufflevector(Bt[n], Bt[n], 4, 5, 6, 7), a0_ = __builtin_shufflevector(At[m], At[m], 0, 1, 2, 3), a1_ = __builtin_shufflevector(At[m], At[m], 4, 5, 6, 7); \
                   asm volatile("v_mfma_i32_16x16x64_i8 %0, %1, %2, 0\n\tv_mfma_i32_16x16x64_i8 %0, %3, %4, %0" : "=&v"(acc[ai][bj][m][n]) : "v"(b0_), "v"(a0_), "v"(b1_), "v"(a1_)); } \
            else { acc[ai][bj][m][n] = __builtin_amdgcn_mfma_f32_16x16x32_bf16(PG8_LO(Bt[n]), PG8_LO(At[m]), (f32x4){0.f, 0.f, 0.f, 0.f}, 0, 0, 0); \
                   acc[ai][bj][m][n] = __builtin_amdgcn_mfma_f32_16x16x32_bf16(PG8_HI(Bt[n]), PG8_HI(At[m]), acc[ai][bj][m][n], 0, 0, 0); } } \
        else if constexpr (MODE == 1) { asm volatile("v_mfma_f32_16x16x128_f8f6f4 %0, %1, %2, %0" : "+v"(acc[ai][bj][m][n]) : "v"(Bt[n]), "v"(At[m])); } \
        else if constexpr (MODE == 2) { const v4i_t b0_ = __builtin_shufflevector(Bt[n], Bt[n], 0, 1, 2, 3), b1_ = __builtin_shufflevector(Bt[n], Bt[n], 4, 5, 6, 7), a0_ = __builtin_shufflevector(At[m], At[m], 0, 1, 2, 3), a1_ = __builtin_shufflevector(At[m], At[m], 4, 5, 6, 7); \
               asm volatile("v_mfma_i32_16x16x64_i8 %0, %1, %2, %0\n\tv_mfma_i32_16x16x64_i8 %0, %3, %4, %0" : "+v"(acc[ai][bj][m][n]) : "v"(b0_), "v"(a0_), "v"(b1_), "v"(a1_)); } \
        else { acc[ai][bj][m][n] = __builtin_amdgcn_mfma_f32_16x16x32_bf16(PG8_LO(Bt[n]), PG8_LO(At[m]), acc[ai][bj][m][n], 0, 0, 0); \
               acc[ai][bj][m][n] = __builtin_amdgcn_mfma_f32_16x16x32_bf16(PG8_HI(Bt[n]), PG8_HI(At[m]), acc[ai][bj][m][n], 0, 0, 0); } } \
        __builtin_amdgcn_s_setprio(0); } while (0)
#define PG8_WAIT_V(n) asm volatile("s_waitcnt vmcnt(" #n ")" ::: "memory")
#define PG8_WAIT_L(n) asm volatile("s_waitcnt lgkmcnt(" #n ")" ::: "memory")
#define PG8_BAR __builtin_amdgcn_s_barrier()
#define PG8_SCHED __builtin_amdgcn_sched_barrier(0)
    Unit cur, nxt; int ui = 0;
    if (!S.next(0, cur)) return;
    f32x4 acc[2][2][4][2];
    v8i_t At[4], B0[2], B1[2];
    const char* cA = cur.A; const char* cB = cur.B; const char* nA = cA;
    if constexpr (GATHER) { PG8_GLOAD(vgc, cur.pm); asm volatile("s_waitcnt vmcnt(0)" ::: "memory"); }
    PG8_STAGE(PG8_SB(0, 0), cB, voffB); PG8_STAGE(PG8_SB(0, 1), cB + hstep, voffB); PG8_STAGE_A(PG8_SA(0, 0), 0, (size_t)0, false); PG8_STAGE_A(PG8_SA(0, 1), 1, (size_t)0, false);
    if (wr == 1) PG8_BAR;
    PG8_WAIT_V(2); PG8_BAR;
    PG8_STAGE(PG8_SB(1, 0), cB + kstep, voffB); PG8_STAGE_A(PG8_SA(1, 0), 0, kstep, false); PG8_STAGE(PG8_SB(1, 1), cB + hstep + kstep, voffB);
    PG8_WAIT_V(6); PG8_BAR;
    for (;;) {
        const bool has_next = S.next(ui + 1, nxt);
        nA = has_next ? nxt.A : cA; const char* nB = has_next ? nxt.B : cB;
        if constexpr (GATHER) { if (has_next && nxt.pm != cur.pm) { PG8_GLOAD(vgn, nxt.pm); asm volatile("s_waitcnt vmcnt(0)" ::: "memory"); } else { vgn[0][0] = vgc[0][0]; vgn[0][1] = vgc[0][1]; vgn[1][0] = vgc[1][0]; vgn[1][1] = vgc[1][1]; } }
#define PG8_PAIR(Z) do { \
            const bool last = (t == nt - 2); \
            const size_t k1 = (size_t)(t + 1) * kstep, k2 = last ? (size_t)0 : (size_t)(t + 2) * kstep, k3 = k2 + kstep;       \
            const char* b2 = last ? nB : cB + (size_t)(t + 2) * kstep; \
            const char* b3 = b2 + kstep; \
            PG8_LDB(B0, 0, 0); PG8_LDB(B1, 0, 1); PG8_SCHED; PG8_LDA(At, 0, 0); PG8_STAGE_A(PG8_SA(1, 1), 1, k1, false); \
            PG8_WAIT_V(8); PG8_WAIT_L(0); PG8_BAR; PG8_MMA(0, 0, At, B0, Z); PG8_MMA(0, 1, At, B1, Z); PG8_BAR; PG8_SCHED; \
            PG8_LDA(At, 0, 1); PG8_STAGE(PG8_SB(0, 0), b2, voffB); PG8_STAGE(PG8_SB(0, 1), b2 + hstep, voffB); PG8_STAGE_A(PG8_SA(0, 0), 0, k2, last); \
            PG8_WAIT_V(8); PG8_WAIT_L(0); PG8_BAR; PG8_MMA(1, 0, At, B0, Z); PG8_MMA(1, 1, At, B1, Z); PG8_BAR; PG8_SCHED; \
            PG8_LDB(B0, 1, 0); PG8_LDB(B1, 1, 1); PG8_SCHED; PG8_LDA(At, 1, 0); PG8_STAGE_A(PG8_SA(0, 1), 1, k2, last); \
            PG8_WAIT_V(8); PG8_WAIT_L(0); PG8_BAR; PG8_MMA(0, 0, At, B0, false); PG8_MMA(0, 1, At, B1, false); PG8_BAR; PG8_SCHED; \
            PG8_LDA(At, 1, 1); PG8_STAGE(PG8_SB(1, 0), b3, voffB); PG8_STAGE(PG8_SB(1, 1), b3 + hstep, voffB); PG8_STAGE_A(PG8_SA(1, 0), 0, k3, last); \
            PG8_WAIT_V(8); PG8_WAIT_L(0); PG8_BAR; PG8_MMA(1, 0, At, B0, false); PG8_MMA(1, 1, At, B1, false); PG8_BAR; PG8_SCHED; } while (0)
        { const int t = 0; PG8_PAIR(true); }
        for (int t = 2; t < nt; t += 2) PG8_PAIR(false);
#undef PG8_PAIR
        if constexpr (ALIGN_EPI) { if (wr == 0) PG8_BAR; }
        if constexpr (MODE != 0) asm volatile("s_nop 15\n\ts_nop 15" ::: "memory");
        E(acc, cur, wr, wc, fr, fq);
        if (!has_next) break;
        cur = nxt; cA = nA; cB = nB; ++ui;
        if constexpr (GATHER) { vgc[0][0] = vgn[0][0]; vgc[0][1] = vgn[0][1]; vgc[1][0] = vgn[1][0]; vgc[1][1] = vgn[1][1]; }
        if constexpr (ALIGN_EPI) { if (wr == 1) PG8_BAR; }
    }
    PG8_WAIT_V(0);
    if constexpr (!ALIGN_EPI) { if (wr == 0) PG8_BAR; }
    PG8_BAR;
#undef PG8_SA
#undef PG8_SB
#undef PG8_STAGE
#undef PG8_STAGE_A
#undef PG8_GLOAD
#undef PG8_LDA
#undef PG8_LDB
#undef PG8_MMA
#undef PG8_LO
#undef PG8_HI
#undef PG8_RD
#undef PG8_WAIT_V
#undef PG8_WAIT_L
#undef PG8_BAR
#undef PG8_SCHED
}
}

#define XB_TMO      128
#define XB_XCNT(j)  (256  + 64 * (j))
#define XB_XSUB(j)  (1280 + 64 * (j))
#define XB_XGEN(j)  (2304 + 64 * (j))
#define XB_TOP      3328
#define XB_TOPGEN   3392
#define XCD_BAR_WORDS 3456
#define XB_SPIN_CAP (1u << 22)

__device__ __forceinline__ unsigned xb_ld(unsigned* p)              { return __hip_atomic_load(p, __ATOMIC_RELAXED, __HIP_MEMORY_SCOPE_AGENT); }
__device__ __forceinline__ unsigned xb_add(unsigned* p, unsigned v) { return __hip_atomic_fetch_add(p, v, __ATOMIC_RELAXED, __HIP_MEMORY_SCOPE_AGENT); }
__device__ __forceinline__ unsigned xb_xcc_id() { return (unsigned)__builtin_amdgcn_s_getreg((3 << 11) | 20) & 0xFu; }
#define XB_SPIN(cond, bar) do { unsigned _sp = 0; while (cond) { __builtin_amdgcn_s_sleep(1); \
    if ((++_sp & 255u) == 0u) { if (xb_ld(&(bar)[XB_TMO])) break; if (_sp > XB_SPIN_CAP) { atomicAdd(&(bar)[XB_TMO], 1u); break; } } } } while (0)

struct XcdBarrier { unsigned* bar; unsigned x; volatile LAS unsigned* st; };

__device__ __forceinline__ XcdBarrier xcd_barrier_post(unsigned* bar, volatile LAS unsigned* st) {
    XcdBarrier b; b.bar = bar; b.x = xb_xcc_id(); b.st = st;
    if (threadIdx.x == 0) (void)xb_add(&bar[XB_XCNT(b.x)], 1u);
    return b;
}
__device__ __forceinline__ void xcd_barrier_complete(unsigned* bar, unsigned x, unsigned& nloc, unsigned& nx) {
    const unsigned G = gridDim.x * gridDim.y * gridDim.z;
    unsigned sum, cnt, mine, sp = 0u;
    for (;;) {
        sum = 0u; cnt = 0u; mine = 0u;
#pragma unroll
        for (unsigned j = 0; j < 16; ++j) { const unsigned c = xb_ld(&bar[XB_XCNT(j)]); sum += c; cnt += (c > 0u) ? 1u : 0u; mine = (j == x) ? c : mine; }
        if (sum == G) break;
        __builtin_amdgcn_s_sleep(1);
        if ((++sp & 255u) == 0u) { if (xb_ld(&bar[XB_TMO])) break; if (sp > XB_SPIN_CAP) { atomicAdd(&bar[XB_TMO], 1u); break; } }
    }
    nloc = mine > 0u ? mine : 1u; nx = cnt > 0u ? cnt : 1u;
}
__device__ __forceinline__ void xcd_barrier(LAS unsigned char* lds0_, int wave_) {
    unsigned l_ = (unsigned)(unsigned long long)lds0_; asm volatile("" : "+s"(l_)); LAS unsigned char* const ldsb = (LAS unsigned char*)l_;
    XcdBarrier b;
    { const volatile LAS unsigned* p = (const volatile LAS unsigned*)(ldsb + LDSCTL_OFF) + 2 * 30;
      const unsigned lo = (unsigned)__builtin_amdgcn_readfirstlane((int)p[0]), hi = (unsigned)__builtin_amdgcn_readfirstlane((int)p[1]);
      b.bar = (unsigned*)(GAS unsigned*)(((unsigned long long)hi << 32) | lo) + CW_BAR; }
    b.x = xb_xcc_id(); b.st = (volatile LAS unsigned*)(ldsb + MISC_OFF) + 8;
    int tid_; asm volatile("v_mbcnt_lo_u32_b32 %0, -1, 0\n\tv_mbcnt_hi_u32_b32 %0, -1, %0" : "=v"(tid_)); tid_ += 64 * wave_;
    asm volatile("s_waitcnt vmcnt(0)" ::: "memory");
    __syncthreads();
    if (tid_ == 0) {
        unsigned* bar = b.bar;
        __builtin_amdgcn_s_waitcnt(0);
        unsigned nloc = b.st[0], nx = b.st[1];
        if (nloc == 0u) { xcd_barrier_complete(bar, b.x, nloc, nx); b.st[0] = nloc; b.st[1] = nx; }
        __builtin_amdgcn_fence(__ATOMIC_ACQUIRE, "agent");
        const unsigned old = xb_add(&bar[XB_XSUB(b.x)], 1u);
        const unsigned gen = old / nloc;
        if (old == gen * nloc && nloc > 1u) __builtin_amdgcn_fence(__ATOMIC_RELEASE, "agent");
        if (old + 1u == (gen + 1u) * nloc) {
            __builtin_amdgcn_fence(__ATOMIC_RELEASE, "agent");
            asm volatile("s_waitcnt vmcnt(0)" ::: "memory");
            const unsigned og = xb_add(&bar[XB_TOP], 1u);
            const unsigned tg = og / nx;
            if (og + 1u == (tg + 1u) * nx) xb_add(&bar[XB_TOPGEN], 1u);
            else XB_SPIN(xb_ld(&bar[XB_TOPGEN]) == tg, bar);
            xb_add(&bar[XB_XGEN(b.x)], 1u);
            asm volatile("s_waitcnt vmcnt(0)" ::: "memory");
        } else {
            XB_SPIN(xb_ld(&bar[XB_XGEN(b.x)]) == gen, bar);
            asm volatile("s_waitcnt vmcnt(0)" ::: "memory");
        }
    }
    __syncthreads();
}

#define XB_LSUB(j)  (3584 + 64 * (j))
#define XB_LGEN(j)  (4608 + 64 * (j))
__device__ __forceinline__ void xcd_local_barrier(LAS unsigned char* lds0_, int wave_) {
    unsigned l_ = (unsigned)(unsigned long long)lds0_; asm volatile("" : "+s"(l_)); LAS unsigned char* const ldsb = (LAS unsigned char*)l_;
    unsigned* bar;
    { const volatile LAS unsigned* p = (const volatile LAS unsigned*)(ldsb + LDSCTL_OFF) + 2 * 30;
      const unsigned lo = (unsigned)__builtin_amdgcn_readfirstlane((int)p[0]), hi = (unsigned)__builtin_amdgcn_readfirstlane((int)p[1]);
      bar = (unsigned*)(GAS unsigned*)(((unsigned long long)hi << 32) | lo) + CW_BAR; }
    const unsigned x = xb_xcc_id(); volatile LAS unsigned* st = (volatile LAS unsigned*)(ldsb + MISC_OFF) + 8;
    int tid_; asm volatile("v_mbcnt_lo_u32_b32 %0, -1, 0\n\tv_mbcnt_hi_u32_b32 %0, -1, %0" : "=v"(tid_)); tid_ += 64 * wave_;
    asm volatile("s_waitcnt vmcnt(0)" ::: "memory");
    __syncthreads();
    if (tid_ == 0) {
        __builtin_amdgcn_s_waitcnt(0);
        const unsigned nloc = st[0];
        __builtin_amdgcn_fence(__ATOMIC_ACQUIRE, "agent");
        const unsigned old = xb_add(&bar[XB_LSUB(x)], 1u);
        const unsigned gen = old / nloc;
        if (old + 1u == (gen + 1u) * nloc) xb_add(&bar[XB_LGEN(x)], 1u);
        else XB_SPIN(xb_ld(&bar[XB_LGEN(x)]) == gen, bar);
        asm volatile("s_waitcnt vmcnt(0)" ::: "memory");
    }
    __syncthreads();
}

struct Frame {
    LAS unsigned char* lds;
    volatile LAS unsigned* MISC;
    int tid, lane, wave, vcu, G, vz, bx, wave0;
    struct InTab { LAS unsigned char* lds;
        __device__ __forceinline__ const float* operator[](int k) const {
            const volatile LAS unsigned* p = (const volatile LAS unsigned*)(lds + LDSCTL_OFF) + 2 * k;
            const unsigned lo = (unsigned)__builtin_amdgcn_readfirstlane((int)p[0]), hi = (unsigned)__builtin_amdgcn_readfirstlane((int)p[1]);
            const GAS float* qg = (const GAS float*)(((unsigned long long)hi << 32) | lo);
            const float* q = (const float*)qg;
            return q; } } in;
    __device__ __forceinline__ float* out() const { return (float*)in[29]; }
    __device__ __forceinline__ unsigned char* ws() const { return (unsigned char*)in[30]; }
    __device__ __forceinline__ gu32* ctl() const { return (gu32*)in[30]; }
};

__device__ __forceinline__ void refresh(Frame& F, LAS unsigned char* lds0) {
    int wv = F.wave0; asm volatile("" : "+s"(wv));
    int t; asm volatile("v_mbcnt_lo_u32_b32 %0, -1, 0\n\tv_mbcnt_hi_u32_b32 %0, -1, %0" : "=v"(t));
    F.lane = t; F.wave = wv; F.tid = wv * 64 + t;
    int bx = blockIdx.x, G = gridDim.x; asm volatile("" : "+s"(bx), "+s"(G)); F.bx = bx; F.G = G; F.vcu = (G % 8 == 0) ? (bx % 8) * (G / 8) + bx / 8 : bx;
    unsigned l = (unsigned)(unsigned long long)lds0; asm volatile("" : "+s"(l)); F.lds = (LAS unsigned char*)l;
    F.MISC = (volatile LAS unsigned*)(F.lds + MISC_OFF); F.in.lds = F.lds;
    int z; asm volatile("v_mov_b32 %0, 0" : "=v"(z)); F.vz = z;
}
__device__ __forceinline__ float shx(float v, int m, int lane) { return __int_as_float(__builtin_amdgcn_ds_bpermute((lane ^ m) << 2, __float_as_int(v))); }
template <int CTRL> __device__ __forceinline__ float dpp_mov(float v) { return __int_as_float(__builtin_amdgcn_update_dpp(0, __float_as_int(v), CTRL, 0xF, 0xF, true)); }
__device__ __forceinline__ float rowlane(float v, int l) { return __int_as_float(__builtin_amdgcn_readlane(__float_as_int(v), l)); }
__device__ __forceinline__ float wave_sum_dpp(float v) {
    v += dpp_mov<0xB1>(v); v += dpp_mov<0x4E>(v); v += dpp_mov<0x141>(v); v += dpp_mov<0x140>(v);
    return (rowlane(v, 0) + rowlane(v, 16)) + (rowlane(v, 32) + rowlane(v, 48));
}
__device__ __forceinline__ float wave_max_dpp(float v) {
    v = fmaxf(v, dpp_mov<0xB1>(v)); v = fmaxf(v, dpp_mov<0x4E>(v)); v = fmaxf(v, dpp_mov<0x141>(v)); v = fmaxf(v, dpp_mov<0x140>(v));
    return fmaxf(fmaxf(rowlane(v, 0), rowlane(v, 16)), fmaxf(rowlane(v, 32), rowlane(v, 48)));
}
__device__ __forceinline__ float wave_sum(float v, int lane) {
#pragma unroll
    for (int o = 1; o < 64; o <<= 1) v += shx(v, o, lane);
    return v;
}

template <int CM  >
__device__ __forceinline__ void transpose_item(const float* W, int K, int N, void* WTv, int mode, float scale, LAS float* scr, int item, int lane, const float* kfac = nullptr, float kf_hi = 1.0f  ) {
    constexpr int KS = CM ? 128 : 64;
    const int nblk = N / 64, kb = item / nblk, nb = item % nblk, k0 = KS * kb, n0 = 64 * nb;
    int drow = (mode == 0 || mode == 3) ? n0 + lane : ((n0 >> 7) * 256 + (n0 & 127) + (mode == 2 ? 128 : 0)) + lane;
    if (mode == 3 && n0 >= C_QCH && n0 < C_VCH) { const int n = n0 + lane, d = n & 63, h = (n >> 6) & 3; drow = (n & ~255) + (d >> 5) * 128 + 32 * h + (d & 31); }
    const int kr = lane >> 4, n4 = (lane & 15) * 4;
    f32x4 vset[2][8];
#pragma unroll
    for (int i = 0; i < 8; ++i) vset[0][i] = __builtin_nontemporal_load((const f32x4*)(W + (size_t)(k0 + 4 * i + kr) * N + n0 + n4));
#pragma unroll
    for (int sub = 0; sub < KS / 32; ++sub) {
        if (sub + 1 < KS / 32) {
#pragma unroll
            for (int i = 0; i < 8; ++i) vset[(sub + 1) & 1][i] = __builtin_nontemporal_load((const f32x4*)(W + (size_t)(k0 + (sub + 1) * 32 + 4 * i + kr) * N + n0 + n4));
        }
#pragma unroll
        for (int i = 0; i < 8; ++i) { LAS float* d = scr + (4 * i + kr) * 65 + n4; const f32x4 t = vset[sub & 1][i]; d[0] = t.x; d[1] = t.y; d[2] = t.z; d[3] = t.w; }
        LDS_WAIT(); asm volatile("" ::: "memory");
        float x[32];
#pragma unroll
        for (int k = 0; k < 32; ++k) x[k] = scr[k * 65 + lane] * scale;
        if (kfac) { const float* kp = kfac + k0 + sub * 32; const float hf = (k0 + sub * 32 >= 768) ? kf_hi : 1.0f;
#pragma unroll
            for (int k = 0; k < 32; ++k) x[k] *= kp[k] * hf; }
        if constexpr (CM == 2) {
            unsigned char* dst = (unsigned char*)WTv + (size_t)drow * K + k0 + sub * 32;
#pragma unroll
            for (int q = 0; q < 2; ++q) { v4u o; o.x = pack4_i8(x[16 * q], x[16 * q + 1], x[16 * q + 2], x[16 * q + 3]); o.y = pack4_i8(x[16 * q + 4], x[16 * q + 5], x[16 * q + 6], x[16 * q + 7]);
                o.z = pack4_i8(x[16 * q + 8], x[16 * q + 9], x[16 * q + 10], x[16 * q + 11]); o.w = pack4_i8(x[16 * q + 12], x[16 * q + 13], x[16 * q + 14], x[16 * q + 15]); *(v4u*)(dst + 16 * q) = o; }
        } else if constexpr (CM == 1) {
            unsigned char* dst = (unsigned char*)WTv + (size_t)drow * K + k0 + sub * 32;
#pragma unroll
            for (int q = 0; q < 2; ++q) { v4u o; o.x = pack4_fp8(x[16 * q], x[16 * q + 1], x[16 * q + 2], x[16 * q + 3]); o.y = pack4_fp8(x[16 * q + 4], x[16 * q + 5], x[16 * q + 6], x[16 * q + 7]);
                o.z = pack4_fp8(x[16 * q + 8], x[16 * q + 9], x[16 * q + 10], x[16 * q + 11]); o.w = pack4_fp8(x[16 * q + 12], x[16 * q + 13], x[16 * q + 14], x[16 * q + 15]); *(v4u*)(dst + 16 * q) = o; }
        } else {
            bf16* dst = (bf16*)WTv + (size_t)drow * K + k0 + sub * 32;
#pragma unroll
            for (int q = 0; q < 4; ++q) { v4u o; o.x = pk2(x[8 * q], x[8 * q + 1]); o.y = pk2(x[8 * q + 2], x[8 * q + 3]); o.z = pk2(x[8 * q + 4], x[8 * q + 5]); o.w = pk2(x[8 * q + 6], x[8 * q + 7]); *(v4u*)(dst + 8 * q) = o; }
        }
        LDS_WAIT(); asm volatile("" ::: "memory");
    }
}

__device__ __forceinline__ float wave_max(float v, int lane) {
#pragma unroll
    for (int o = 1; o < 64; o <<= 1) v = fmaxf(v, shx(v, o, lane));
    return v;
}
__device__ __forceinline__ void dense_amax(Frame& F) {
    const int gw = F.vcu * NWAVES + F.wave, NGW = F.G * NWAVES;
    constexpr int NV = DM * DFF / 256;
#pragma unroll
    for (int t = 0; t < 4; ++t) {
        const float* W = ((t & 1) ? F.in[23] : F.in[22]) + (size_t)(t >> 1) * DM * DFF;
        float m = 0.f;
        for (int idx = gw; idx < NV; idx += NGW) { const f32x4 v = __builtin_nontemporal_load((const f32x4*)W + (size_t)idx * 64 + F.lane); m = fmaxf(m, fmaxf(fmaxf(fabsf(v.x), fabsf(v.y)), fmaxf(fabsf(v.z), fabsf(v.w)))); }
        m = wave_max(m, F.lane);
        if (F.lane == 0) __hip_atomic_fetch_max((unsigned*)(F.ctl() + CW_AMAX + 64 * t), __float_as_uint(m), __ATOMIC_RELAXED, __HIP_MEMORY_SCOPE_AGENT);
    }
}
__device__ __forceinline__ void win_amax(Frame& F) {
    const int gw = F.vcu * NWAVES + F.wave, NGW = F.G * NWAVES;
    constexpr int NCB = INC / 256, NKC = DM / 32, NIT = 4 * NCB * NKC;
    for (int it = gw; it < NIT; it += NGW) { const int l = it / (NCB * NKC), r = it % (NCB * NKC), cb = r % NCB, kc = r / NCB;
        const float* W = F.in[2] + (size_t)l * DM * INC + (size_t)(kc * 32) * INC + cb * 256 + 4 * F.lane;
        f32x4 m = (f32x4){0.f, 0.f, 0.f, 0.f};
#pragma unroll 8
        for (int k = 0; k < 32; ++k) { const f32x4 v = *(const f32x4*)(W + (size_t)k * INC); m.x = fmaxf(m.x, fabsf(v.x)); m.y = fmaxf(m.y, fabsf(v.y)); m.z = fmaxf(m.z, fabsf(v.z)); m.w = fmaxf(m.w, fabsf(v.w)); }
        unsigned* dst = (unsigned*)(F.ctl() + CW_CHMAX + l * INC + cb * 256 + 4 * F.lane);
        __hip_atomic_fetch_max(dst, __float_as_uint(m.x), __ATOMIC_RELAXED, __HIP_MEMORY_SCOPE_AGENT); __hip_atomic_fetch_max(dst + 1, __float_as_uint(m.y), __ATOMIC_RELAXED, __HIP_MEMORY_SCOPE_AGENT);
        __hip_atomic_fetch_max(dst + 2, __float_as_uint(m.z), __ATOMIC_RELAXED, __HIP_MEMORY_SCOPE_AGENT); __hip_atomic_fetch_max(dst + 3, __float_as_uint(m.w), __ATOMIC_RELAXED, __HIP_MEMORY_SCOPE_AGENT);
    }
}
__device__ __forceinline__ void win_convert(Frame& F) {
    LAS float* scr = (LAS float*)(F.lds + F.wave * 16384);
    const int gw = F.vcu * NWAVES + F.wave, NGW = F.G * NWAVES;
    constexpr int I_IN8 = (DM / 128) * (INC / 64);
    for (int it = gw; it < 4 * I_IN8; it += NGW) { const int l = it / I_IN8, item = it % I_IN8, n = 64 * (item % (INC / 64)) + F.lane;
        const float cm = __uint_as_float(__hip_atomic_load((unsigned*)(F.ctl() + CW_CHMAX + l * INC + n), __ATOMIC_RELAXED, __HIP_MEMORY_SCOPE_AGENT));
        if (item < INC / 64) { int drow = n; if (n >= C_QCH && n < C_VCH) { const int d = n & 63, h = (n >> 6) & 3; drow = (n & ~255) + (d >> 5) * 128 + 32 * h + (d & 31); }
            ((float*)(F.ws() + WS_SWIN))[l * INC + drow] = cm * (1.0f / 127.0f); }
        transpose_item<2>(F.in[2] + (size_t)l * DM * INC, DM, INC, (unsigned char*)(F.ws() + WS_WIN) + (size_t)l * INC * DM, 3, cm > 0.f ? 127.0f / cm : 0.f, scr, item, F.lane); }
}
__device__ __forceinline__ float df_head_scale(int l) { return 1.0f - (0.8f - 0.6f * expf(-0.3f * (float)l)); }
__device__ __forceinline__ void wout_amax(Frame& F) {
    const int gw = F.vcu * NWAVES + F.wave, NGW = F.G * NWAVES;
    constexpr int NCB = DM / 256, NKC = DM / 32, NIT = 4 * NCB * NKC;
    for (int it = gw; it < NIT; it += NGW) { const int l = it / (NCB * NKC), r = it % (NCB * NKC), cb = r % NCB, kc = r / NCB;
        const float* W = F.in[20] + (size_t)l * DM * DM + (size_t)(kc * 32) * DM + cb * 256 + 4 * F.lane;
        const float* gp = F.in[19] + l * DM + kc * 32; const float hf = (kc * 32 >= 768) ? df_head_scale(l) : 1.0f;
        f32x4 m = (f32x4){0.f, 0.f, 0.f, 0.f};
#pragma unroll 8
        for (int k = 0; k < 32; ++k) { const f32x4 v = *(const f32x4*)(W + (size_t)k * DM); const float gk = fabsf(gp[k] * hf);
            m.x = fmaxf(m.x, fabsf(v.x) * gk); m.y = fmaxf(m.y, fabsf(v.y) * gk); m.z = fmaxf(m.z, fabsf(v.z) * gk); m.w = fmaxf(m.w, fabsf(v.w) * gk); }
        unsigned* dst = (unsigned*)(F.ctl() + CW_CHMAXO + l * DM + cb * 256 + 4 * F.lane);
        __hip_atomic_fetch_max(dst, __float_as_uint(m.x), __ATOMIC_RELAXED, __HIP_MEMORY_SCOPE_AGENT); __hip_atomic_fetch_max(dst + 1, __float_as_uint(m.y), __ATOMIC_RELAXED, __HIP_MEMORY_SCOPE_AGENT);
        __hip_atomic_fetch_max(dst + 2, __float_as_uint(m.z), __ATOMIC_RELAXED, __HIP_MEMORY_SCOPE_AGENT); __hip_atomic_fetch_max(dst + 3, __float_as_uint(m.w), __ATOMIC_RELAXED, __HIP_MEMORY_SCOPE_AGENT);
    }
}
__device__ __forceinline__ void wout_convert(Frame& F) {
    LAS float* scr = (LAS float*)(F.lds + F.wave * 16384);
    const int gw = F.vcu * NWAVES + F.wave, NGW = F.G * NWAVES;
    constexpr int I_OUT8 = (DM / 128) * (DM / 64);
    for (int it = gw; it < 4 * I_OUT8; it += NGW) { const int l = it / I_OUT8, item = it % I_OUT8, n = 64 * (item % (DM / 64)) + F.lane;
        const float cm = __uint_as_float(__hip_atomic_load((unsigned*)(F.ctl() + CW_CHMAXO + l * DM + n), __ATOMIC_RELAXED, __HIP_MEMORY_SCOPE_AGENT));
        if (item < DM / 64) ((float*)(F.ws() + WS_SWOUT))[l * DM + n] = cm * (1.0f / 127.0f) * (8.0f / 127.0f);
        transpose_item<2>(F.in[20] + (size_t)l * DM * DM, DM, DM, (unsigned char*)(F.ws() + WS_WOUT) + (size_t)l * DM * DM, 0, cm > 0.f ? 127.0f / cm : 0.f, scr, item, F.lane, F.in[19] + l * DM, df_head_scale(l)); }
}
__device__ __forceinline__ void dense_up_convert(Frame& F) {
    LAS float* scr = (LAS float*)(F.lds + F.wave * 16384);
    constexpr int I_FU = (DM / 128) * (DFF / 64);
    unsigned* head = (unsigned*)(F.ctl() + CW_DCQ);
    for (;;) {
        unsigned id = 0u;
        if (F.lane == 0) id = __hip_atomic_fetch_add(head, 1u, __ATOMIC_RELAXED, __HIP_MEMORY_SCOPE_AGENT);
        id = (unsigned)__builtin_amdgcn_readfirstlane((int)id);
        if (id >= (unsigned)(4 * I_FU)) break;
        const int q = (int)id / I_FU, i = q >> 1, w3 = q & 1;
        const float amax = __uint_as_float(__hip_atomic_load((unsigned*)(F.ctl() + CW_AMAX + 64 * q), __ATOMIC_RELAXED, __HIP_MEMORY_SCOPE_AGENT));
        transpose_item<2>((w3 ? F.in[23] : F.in[22]) + (size_t)i * DM * DFF, DM, DFF, (unsigned char*)(F.ws() + WS_WFUP) + (size_t)i * 2 * DFF * DM, w3 ? 2 : 1, amax > 0.f ? 127.0f / amax : 0.f, scr, (int)id % I_FU, F.lane);
    }
}
__device__ __forceinline__ void prologue_convert(Frame& F) {
    LAS float* scr = (LAS float*)(F.lds + F.wave * 16384);
    const int gw = F.vcu * NWAVES + F.wave, NGW = F.G * NWAVES;
    constexpr int KSF = DENSE_FP8 ? 128 : 64, KSFD = (DENSE_FP8 || DENSE_DN_FP8) ? 128 : 64;
    constexpr int I_IN = (DM / 64) * (INC / 64), I_OUT = (DM / 64) * (DM / 64), I_FU = (DM / KSF) * (DFF / 64), I_FD = (DFF / KSFD) * (DM / 64), I_GL = (256 / 64) * (256 / 64);
    constexpr int NITEMS = 4 * I_IN + 4 * I_OUT + 4 * I_FU + 2 * I_FD + 4 * I_GL;
    bf16* WIN = (bf16*)(F.ws() + WS_WIN); bf16* WOUT = (bf16*)(F.ws() + WS_WOUT); bf16* WFUP = (bf16*)(F.ws() + WS_WFUP); bf16* WFDN = (bf16*)(F.ws() + WS_WFDN);
    for (int it = gw; it < NITEMS; it += NGW) {
        int r = it;
#if WIN_I8
        if (r < 4 * I_IN) { continue; } r -= 4 * I_IN;
#else
        if (r < 4 * I_IN) { const int l = r / I_IN; transpose_item<0>(F.in[2] + (size_t)l * DM * INC, DM, INC, WIN + (size_t)l * INC * DM, 3, 1.0f, scr, r % I_IN, F.lane); continue; } r -= 4 * I_IN;
#endif
#if WOUT_I8
        if (r < 4 * I_OUT) { continue; } r -= 4 * I_OUT;
#else
        if (r < 4 * I_OUT) { const int l = r / I_OUT; transpose_item<0>(F.in[20] + (size_t)l * DM * DM, DM, DM, WOUT + (size_t)l * DM * DM, 0, 1.0f, scr, r % I_OUT, F.lane); continue; } r -= 4 * I_OUT;
#endif
#if DENSE_UP_I8
        if (r < 4 * I_FU) { continue; } r -= 4 * I_FU;
#if DENSE_DN_FP8
        if (r < 2 * I_FD) { const int i = r / I_FD; transpose_item<1>(F.in[24] + (size_t)i * DFF * DM, DFF, DM, (unsigned char*)WFDN + (size_t)i * DM * DFF, 0, WGT8, scr, r % I_FD, F.lane); continue; } r -= 2 * I_FD;
#else
        if (r < 2 * I_FD) { const int i = r / I_FD; transpose_item<0>(F.in[24] + (size_t)i * DFF * DM, DFF, DM, WFDN + (size_t)i * DM * DFF, 0, 1.0f, scr, r % I_FD, F.lane); continue; } r -= 2 * I_FD;
#endif
#elif DENSE_FP8
        if (r < 4 * I_FU) { const int q = r / I_FU, i = q >> 1, w3 = q & 1; transpose_item<1>((w3 ? F.in[23] : F.in[22]) + (size_t)i * DM * DFF, DM, DFF, (unsigned char*)WFUP + (size_t)i * 2 * DFF * DM, w3 ? 2 : 1, WGT8, scr, r % I_FU, F.lane); continue; } r -= 4 * I_FU;
        if (r < 2 * I_FD) { const int i = r / I_FD; transpose_item<1>(F.in[24] + (size_t)i * DFF * DM, DFF, DM, (unsigned char*)WFDN + (size_t)i * DM * DFF, 0, WGT8, scr, r % I_FD, F.lane); continue; } r -= 2 * I_FD;
#else
        if (r < 4 * I_FU) { const int q = r / I_FU, i = q >> 1, w3 = q & 1; transpose_item<0>((w3 ? F.in[23] : F.in[22]) + (size_t)i * DM * DFF, DM, DFF, WFUP + (size_t)i * 2 * DFF * DM, w3 ? 2 : 1, 1.0f, scr, r % I_FU, F.lane); continue; } r -= 4 * I_FU;
        if (r < 2 * I_FD) { const int i = r / I_FD; transpose_item<0>(F.in[24] + (size_t)i * DFF * DM, DFF, DM, WFDN + (size_t)i * DM * DFF, 0, 1.0f, scr, r % I_FD, F.lane); continue; } r -= 2 * I_FD;
#endif
        { const int l = r / I_GL; transpose_item<0>(F.in[11] + (size_t)l * 65536, 256, 256, (bf16*)(F.ws() + (1 * MiB + 65536)) + (size_t)l * 65536, 0, 1.0f, scr, r % I_GL, F.lane); }
    }
}
__device__ __forceinline__ void moe_convert_half(Frame& F, int mi, int half, int maxitems = 0x7fffffff) {
    LAS float* scr = (LAS float*)(F.lds + F.wave * 16384);
    constexpr int KSF = MOE_FP8 ? 128 : 64;
    constexpr int I_MU = (DM / KSF) * (DFE / 64), I_MD = (DFE / KSF) * (DM / 64);
    constexpr int NITEMS = 16 * I_MU + 8 * I_MD, NHALF = NITEMS / 2;
    bf16* WMUP = (bf16*)(F.ws() + WS_WMUP + (size_t)mi * WMUP_LAYER); bf16* WMDN = (bf16*)(F.ws() + WS_WMDN + (size_t)mi * WMDN_LAYER);
    unsigned* head = (unsigned*)(F.ctl() + CW_CVQ + 64 * (mi * 2 + half));
    for (int taken = 0; taken < maxitems; ++taken) {
        unsigned id = 0u;
        if (F.lane == 0) id = __hip_atomic_fetch_add(head, 1u, __ATOMIC_RELAXED, __HIP_MEMORY_SCOPE_AGENT);
        id = (unsigned)__builtin_amdgcn_readfirstlane((int)id);
        if (id >= (unsigned)NHALF) break;
        int r = (int)id + half * NHALF;
        if (r < 16 * I_MU) { const int q = r / I_MU, e = q >> 1, w3 = q & 1;
#if MOE_FP8
            transpose_item<1>((w3 ? F.in[27] : F.in[26]) + ((size_t)mi * NE + e) * DM * DFE, DM, DFE, (unsigned char*)WMUP + (size_t)e * 2 * DFE * DM, w3 ? 2 : 1, WGT8, scr, r % I_MU, F.lane); continue; } r -= 16 * I_MU;
        { const int e = r / I_MD; transpose_item<1>(F.in[28] + ((size_t)mi * NE + e) * DFE * DM, DFE, DM, (unsigned char*)WMDN + (size_t)e * DM * DFE, 0, WGT8, scr, r % I_MD, F.lane); }
#else
            transpose_item<0>((w3 ? F.in[27] : F.in[26]) + ((size_t)mi * NE + e) * DM * DFE, DM, DFE, WMUP + (size_t)e * 2 * DFE * DM, w3 ? 2 : 1, 1.0f, scr, r % I_MU, F.lane); continue; } r -= 16 * I_MU;
        { const int e = r / I_MD; transpose_item<0>(F.in[28] + ((size_t)mi * NE + e) * DFE * DM, DFE, DM, WMDN + (size_t)e * DM * DFE, 0, 1.0f, scr, r % I_MD, F.lane); }
#endif
    }
}

__device__ __forceinline__ void norm_phase(Frame& F, const float* xsrc, bool combine, const float* gain, bool route, const float* wr_, int mi, bool norm, int omode  , size_t rs_off = WS_RS) {
    bf16* XR = (bf16*)(F.ws() + WS_XRES);
    const int gw = F.vcu * NWAVES + F.wave, NGW = F.G * NWAVES;
    bf16* H = (bf16*)(F.ws() + ((route && MOE_FP8) ? WS_HPERM : WS_H)); const bf16* YP = (const bf16*)(F.ws() + WS_YPERM);
    const int4* TS = (const int4*)(F.ws() + WS_TOKSLOT); int4* TI = (int4*)(F.ws() + WS_TOKINFO);
    float* const rsp = (float*)(F.ws() + rs_off); float* const outp = F.out();
    if (route) { if (F.tid < 8) F.MISC[16 + F.tid] = 0u; __syncthreads(); }
    f32x4 wq[32];
    if (route) {
#pragma unroll
        for (int j = 0; j < 4; ++j)
#pragma unroll
            for (int c = 0; c < 4; ++c) { const int k = 4 * F.lane + 256 * j + c; wq[(j * 4 + c) * 2] = *(const f32x4*)(wr_ + (size_t)k * 8); wq[(j * 4 + c) * 2 + 1] = *(const f32x4*)(wr_ + (size_t)k * 8 + 4); }
    }
    f32x4 g[4];
    if (norm) {
#pragma unroll
        for (int j = 0; j < 4; ++j) g[j] = *(const f32x4*)(gain + 4 * F.lane + 256 * j);
    }
#define NP_LOAD(m_, R32, R16) do { if (xsrc) { const f32x4* xr_ = (const f32x4*)(xsrc + (size_t)(m_) * DM) + F.lane; _Pragma("unroll") for (int j = 0; j < 4; ++j) R32[j] = xr_[64 * j]; } \
                                   else { const v2u* xr_ = (const v2u*)(XR + (size_t)(m_) * DM) + F.lane; _Pragma("unroll") for (int j = 0; j < 4; ++j) R16[j] = xr_[64 * j]; } } while (0)
    f32x4 c32[4], n32[4]; v2u c16[4], n16[4];
#pragma unroll
    for (int j = 0; j < 4; ++j) { c32[j] = (f32x4){0.f, 0.f, 0.f, 0.f}; n32[j] = c32[j]; c16[j] = (v2u){0u, 0u}; n16[j] = c16[j]; }
    const bool xrows = (F.G == 256);
#define NP_ROW(i_) (xrows ? ((((i_) & 2047) >> 8) * 4096 + ((i_) & 255) + 256 * ((i_) >> 11)) : (i_))
    if (gw < NTOK) NP_LOAD(NP_ROW(gw), c32, c16);
    for (int mi_ = gw; mi_ < NTOK; mi_ += NGW) {
        const int m = NP_ROW(mi_);
        if (mi_ + NGW < NTOK) NP_LOAD(NP_ROW(mi_ + NGW), n32, n16);
        f32x4 v[4];
        if (xsrc) {
#pragma unroll
            for (int j = 0; j < 4; ++j) v[j] = c32[j];
        } else {
#pragma unroll
            for (int j = 0; j < 4; ++j) v[j] = (f32x4){lo_bf(c16[j].x), hi_bf(c16[j].x), lo_bf(c16[j].y), hi_bf(c16[j].y)}; }
#pragma unroll
        for (int j = 0; j < 4; ++j) { c32[j] = n32[j]; c16[j] = n16[j]; }
        if (combine) {
            const int4 ts = TS[m + F.vz]; const float g0 = __int_as_float(ts.z), g1 = __int_as_float(ts.w);
            const v2u* y0 = (const v2u*)(YP + (size_t)ts.x * DM) + F.lane; const v2u* y1 = (const v2u*)(YP + (size_t)ts.y * DM) + F.lane;
#pragma unroll
            for (int j = 0; j < 4; ++j) { const v2u a = y0[64 * j], b = y1[64 * j];
                v[j].x += g0 * lo_bf(a.x) + g1 * lo_bf(b.x); v[j].y += g0 * hi_bf(a.x) + g1 * hi_bf(b.x);
                v[j].z += g0 * lo_bf(a.y) + g1 * lo_bf(b.y); v[j].w += g0 * hi_bf(a.y) + g1 * hi_bf(b.y); }
            if (norm) { v2u* xo = (v2u*)(XR + (size_t)m * DM) + F.lane;
#pragma unroll
                for (int j = 0; j < 4; ++j) { v2u o; o.x = pk2(v[j].x, v[j].y); o.y = pk2(v[j].z, v[j].w); xo[64 * j] = o; }
            } else { f32x4* xo = (f32x4*)(outp + (size_t)m * DM) + F.lane;
#pragma unroll
                for (int j = 0; j < 4; ++j) xo[64 * j] = v[j]; }
        }
        if (!norm) continue;
        float s2 = 0.f;
#pragma unroll
        for (int j = 0; j < 4; ++j) s2 += (v[j].x * v[j].x + v[j].y * v[j].y) + (v[j].z * v[j].z + v[j].w * v[j].w);
        const float rs = 1.0f / sqrtf(wave_sum_dpp(s2) * (1.0f / DM) + EPS);
#pragma unroll
        for (int j = 0; j < 4; ++j) v[j] = v[j] * rs * g[j];
        if (omode == 2) {
            float am = 0.f;
#pragma unroll
            for (int j = 0; j < 4; ++j) am = fmaxf(am, fmaxf(fmaxf(fabsf(v[j].x), fabsf(v[j].y)), fmaxf(fabsf(v[j].z), fabsf(v[j].w))));
            am = wave_max_dpp(am);
            const float qs = am > 0.f ? 127.0f / am : 0.f;
            unsigned* o4 = (unsigned*)((unsigned char*)H + (size_t)m * DM) + F.lane;
#pragma unroll
            for (int j = 0; j < 4; ++j) o4[64 * j] = pack4_i8(v[j].x * qs, v[j].y * qs, v[j].z * qs, v[j].w * qs);
            if (F.lane == 0) rsp[m] = am * (1.0f / 127.0f);
        } else if (omode == 1) { unsigned* o4 = (unsigned*)((unsigned char*)H + (size_t)m * DM) + F.lane;
#pragma unroll
            for (int j = 0; j < 4; ++j) o4[64 * j] = pack4_fp8(v[j].x * ACT8, v[j].y * ACT8, v[j].z * ACT8, v[j].w * ACT8);
        } else { unsigned long long* o8 = (unsigned long long*)(H + (size_t)m * DM) + F.lane;
#pragma unroll
            for (int j = 0; j < 4; ++j) o8[64 * j] = (unsigned long long)pk2(v[j].x, v[j].y) | ((unsigned long long)pk2(v[j].z, v[j].w) << 32); }
        if (route) {
            float lg[8];
#pragma unroll
            for (int e = 0; e < 8; ++e) lg[e] = 0.f;
#pragma unroll
            for (int j = 0; j < 4; ++j) {
#pragma unroll
                for (int c = 0; c < 4; ++c) { const f32x4 w0 = wq[(j * 4 + c) * 2], w1 = wq[(j * 4 + c) * 2 + 1]; const float xv = v[j][c];
                    lg[0] += xv * w0.x; lg[1] += xv * w0.y; lg[2] += xv * w0.z; lg[3] += xv * w0.w; lg[4] += xv * w1.x; lg[5] += xv * w1.y; lg[6] += xv * w1.z; lg[7] += xv * w1.w; }
            }
#pragma unroll
            for (int e = 0; e < 8; ++e) lg[e] = wave_sum_dpp(lg[e]);
            int e0 = 0; float b0 = lg[0];
#pragma unroll
            for (int e = 1; e < 8; ++e) if (lg[e] > b0) { b0 = lg[e]; e0 = e; }
            int e1 = -1; float b1 = -3.0e38f;
#pragma unroll
            for (int e = 0; e < 8; ++e) if (e != e0 && lg[e] > b1) { b1 = lg[e]; e1 = e; }
            const float p1 = __expf(b1 - b0); const float g0 = 1.0f / (1.0f + p1), g1 = p1 / (1.0f + p1);
            if (F.lane == 0) { TI[m] = make_int4(e0, e1, __float_as_int(g0), __float_as_int(g1));
                __hip_atomic_fetch_add((LAS unsigned*)(F.lds + MISC_OFF) + 16 + e0, 1u, __ATOMIC_RELAXED, __HIP_MEMORY_SCOPE_WORKGROUP); __hip_atomic_fetch_add((LAS unsigned*)(F.lds + MISC_OFF) + 16 + e1, 1u, __ATOMIC_RELAXED, __HIP_MEMORY_SCOPE_WORKGROUP); }
        }
    }
#undef NP_LOAD
    if (route) { __syncthreads(); if (F.tid < 8) { const unsigned c = F.MISC[16 + F.tid]; if (c) __hip_atomic_fetch_add((unsigned*)(F.ctl() + CW_CNT + 64 * (mi * 8 + F.tid)), c, __ATOMIC_RELAXED, __HIP_MEMORY_SCOPE_AGENT); } }
}

__device__ __forceinline__ int moe_tile_table(Frame& F, int mi) {
    __syncthreads();
    if (F.tid < 8) F.MISC[48 + F.tid] = __hip_atomic_load((unsigned*)(F.ctl() + CW_CNT + 64 * (mi * 8 + F.tid)), __ATOMIC_RELAXED, __HIP_MEMORY_SCOPE_AGENT);
    __syncthreads();
    if (F.tid == 0) { int acc = 0;
        for (int e = 0; e < 8; ++e) { F.MISC[32 + e] = (unsigned)acc; const unsigned c = F.MISC[48 + e]; acc += (int)((c + 255u) >> 8); }
        F.MISC[40] = (unsigned)acc; }
    __syncthreads();
    return (int)F.MISC[40];
}
__device__ __forceinline__ void moe_scatter(Frame& F, int mi) {
    (void)moe_tile_table(F, mi);
    const int gw = F.vcu * NWAVES + F.wave, NGW = F.G * NWAVES;
    const int4* TI = (const int4*)(F.ws() + WS_TOKINFO); int4* TS = (int4*)(F.ws() + WS_TOKSLOT);
    const bf16* H = (const bf16*)(F.ws() + WS_H); bf16* HP = (bf16*)(F.ws() + WS_HPERM);
    int rs[8];
#pragma unroll
    for (int e = 0; e < 8; ++e) rs[e] = (int)F.MISC[32 + e] * 256;
#if MOE_FP8
    { int* ST = (int*)(F.ws() + WS_SLOTTOK);
      for (int e = 0; e < 8; ++e) { const int cnt_e = (int)F.MISC[48 + e];
          const int end_e = (int)F.MISC[32 + e + 1] * 256;
          for (int i = rs[e] + cnt_e + F.vcu * (NWAVES * 64) + F.tid; i < end_e; i += F.G * NWAVES * 64) ST[i] = 0; } }
#endif
    for (int item = gw; item < NTOK / 64; item += NGW) {
        const int tok = item * 64 + F.lane; const int4 ti = TI[tok];
        int s0 = 0, s1 = 0;
        unsigned base[8]; int rank[8];
#pragma unroll
        for (int e = 0; e < 8; ++e) {
            const bool has = (ti.x == e) || (ti.y == e);
            const unsigned long long mask = __ballot(has); const int n = __popcll(mask);
            base[e] = 0u;
            if (F.lane == 0 && n > 0) base[e] = __hip_atomic_fetch_add((unsigned*)(F.ctl() + CW_CUR + 64 * (mi * 8 + e)), (unsigned)n, __ATOMIC_RELAXED, __HIP_MEMORY_SCOPE_AGENT);
            rank[e] = __popcll(mask & ((1ull << F.lane) - 1ull));
        }
#pragma unroll
        for (int e = 0; e < 8; ++e) {
            const int slot = rs[e] + __builtin_amdgcn_readfirstlane((int)base[e]) + rank[e];
            if (ti.x == e) s0 = slot; if (ti.y == e) s1 = slot;
        }
        TS[tok] = make_int4(s0, s1, ti.z, ti.w);
#if MOE_FP8
        { int* ST = (int*)(F.ws() + WS_SLOTTOK); ST[s0] = tok; ST[s1] = tok; }
        for (int j = 0; j < 0; ++j) {
#else
        for (int j = 0; j < 64; ++j) {
#endif
            const int d0 = __builtin_amdgcn_readlane(s0, j), d1 = __builtin_amdgcn_readlane(s1, j);
#if MOE_FP8
            const v4u a = *((const v4u*)((const unsigned char*)H + (size_t)(item * 64 + j) * DM) + F.lane);
            *((v4u*)((unsigned char*)HP + (size_t)d0 * DM) + F.lane) = a; *((v4u*)((unsigned char*)HP + (size_t)d1 * DM) + F.lane) = a;
#else
            const v4u* src = (const v4u*)(H + (size_t)(item * 64 + j) * DM) + F.lane; const v4u a = src[0], b = src[64];
            v4u* q0 = (v4u*)(HP + (size_t)d0 * DM) + F.lane; v4u* q1 = (v4u*)(HP + (size_t)d1 * DM) + F.lane;
            q0[0] = a; q0[64] = b; q1[0] = a; q1[64] = b;
#endif
        }
    }
}

namespace fa {
typedef float f32x16 __attribute__((ext_vector_type(16)));
typedef short s16x4 __attribute__((ext_vector_type(4)));
typedef short v4i16_t __attribute__((ext_vector_type(4)));
constexpr float LOG2E = 1.4426950408889634f;
constexpr int KV_BUF = 16384;
constexpr int KV_RING = 5;
constexpr int OFF_WSF = KV_RING * KV_BUF;
constexpr int OFF_CNT = OFF_WSF + 2048;
constexpr int OFF_BT = OFF_CNT + 64;
constexpr int OFF_OST = 0;
constexpr int OST_ROW = 68, OST_WAVE = 32 * OST_ROW * 4;
static_assert(OFF_BT + 257 * 4 <= RING_BYTES && OFF_OST + 8 * OST_WAVE <= OFF_WSF, "attention LDS map");
#define C0R(r) (float)(((r) & 3) + 8 * ((r) >> 2))
__device__ __forceinline__ int crow(int r, int hi) { return (r & 3) + 8 * (r >> 2) + 4 * hi; }
struct TileRegs { v4u k, v; };
__device__ __forceinline__ void tile_load(TileRegs& R, const bf16* P, size_t row0, int kcol, int vcol, int tid_, int khi = 32) {
    int tid = tid_; asm volatile("" : "+v"(tid));
    const int key = tid >> 3, c = tid & 7;
    R.k = *(const v4u*)(P + (row0 + key) * INC + kcol + (c >> 2) * khi + (c & 3) * 8);
    R.v = *(const v4u*)(P + (row0 + key) * INC + vcol + c * 8);
}
__device__ __forceinline__ void tile_write(const TileRegs& R, LAS unsigned char* Kb, int tid_) {
    int tid = tid_; asm volatile("" : "+v"(tid));
    const int key = tid >> 3, c = tid & 7;
    *(LAS v4u*)(Kb + c * 1024 + key * 16) = R.k;
    *(LAS v4u*)(Kb + 8192 + ((c >> 2) * 4 + (key >> 4)) * 1024 + (key & 15) * 64 + (c & 3) * 16) = R.v;
}
__device__ __forceinline__ void tile_dma(const bf16* P, size_t row0, int kcol, int vcol, LAS unsigned char* Kb, int lane_, int w, int khi = 32) {
    int lane = lane_; asm volatile("" : "+v"(lane));
    const unsigned ko = (unsigned)(lane * INC + (w >> 2) * khi + (w & 3) * 8) * 2u;
    const unsigned vo = (unsigned)(((w & 3) * 16 + (lane >> 2)) * INC + (w >> 2) * 32 + (lane & 3) * 8) * 2u;
    const char* gk = (const char*)(P + row0 * INC + kcol); const char* gv = (const char*)(P + row0 * INC + vcol);
    __builtin_amdgcn_global_load_lds((const GAS unsigned*)(gk + ko), (LAS unsigned*)(Kb + w * 1024), 16, 0, 0);
    __builtin_amdgcn_global_load_lds((const GAS unsigned*)(gv + vo), (LAS unsigned*)(Kb + 8192 + w * 1024), 16, 0, 0);
}
__device__ __forceinline__ void tile_dma_wait() { asm volatile("s_waitcnt vmcnt(0)" ::: "memory"); }
__device__ __forceinline__ bf16x8 kfrag(const LAS unsigned char* Kb, int chunk, int key) { return *(const LAS bf16x8*)(Kb + chunk * 1024 + key * 16); }
__device__ __forceinline__ s16x4 vtr(const LAS unsigned char* p) { return __builtin_bit_cast(s16x4, __builtin_amdgcn_ds_read_tr16_b64_v4i16((LAS v4i16_t*)p)); }
__device__ __forceinline__ bf16x8 vfrag(const LAS unsigned char* vp, int d0, int ks) {
    const s16x4 lo = vtr(vp + d0 * 4096 + ks * 1024), hi = vtr(vp + d0 * 4096 + ks * 1024 + 512);
    return (bf16x8){lo[0], lo[1], lo[2], lo[3], hi[0], hi[1], hi[2], hi[3]};
}
__device__ __forceinline__ bf16x8 qfrag(const bf16* p, float scale) {
    const v4u a = *(const v4u*)p; v4u o;
    o.x = pk2(lo_bf(a.x) * scale, hi_bf(a.x) * scale); o.y = pk2(lo_bf(a.y) * scale, hi_bf(a.y) * scale);
    o.z = pk2(lo_bf(a.z) * scale, hi_bf(a.z) * scale); o.w = pk2(lo_bf(a.w) * scale, hi_bf(a.w) * scale);
    return __builtin_bit_cast(bf16x8, o);
}
__device__ __forceinline__ float swap_max(float m) { auto rr = __builtin_amdgcn_permlane32_swap(__float_as_uint(m), __float_as_uint(m), false, false); return fmaxf(__uint_as_float(rr[0]), __uint_as_float(rr[1])); }
__device__ __forceinline__ float swap_sum(float m) { auto rr = __builtin_amdgcn_permlane32_swap(__float_as_uint(m), __float_as_uint(m), false, false); return __uint_as_float(rr[0]) + __uint_as_float(rr[1]); }
__device__ __forceinline__ float max3f(float a, float b, float c) { float r; asm("v_max3_f32 %0, %1, %2, %3" : "=v"(r) : "v"(a), "v"(b), "v"(c)); return r; }
__device__ __forceinline__ float rowmax32(const f32x16& a, const f32x16& b) {
    float m0 = max3f(a[0], a[1], b[0]), m1 = max3f(a[2], a[3], b[1]); m0 = max3f(m0, b[2], b[3]);
#pragma unroll
    for (int r = 4; r < 16; r += 4) { m0 = max3f(m0, a[r], a[r + 1]); m1 = max3f(m1, a[r + 2], a[r + 3]); m0 = max3f(m0, b[r], b[r + 1]); m1 = max3f(m1, b[r + 2], b[r + 3]); }
    float m; asm("v_max_f32_e32 %0, %1, %2" : "=v"(m) : "v"(m0), "v"(m1));
    return swap_max(m);
}
__device__ __forceinline__ unsigned cvtpk(float lo, float hi) { typedef float f2 __attribute__((ext_vector_type(2))); typedef __bf16 b2 __attribute__((ext_vector_type(2))); f2 v = {lo, hi}; b2 b = __builtin_convertvector(v, b2); return __builtin_bit_cast(unsigned, b); }
__device__ __forceinline__ void pack_p(const f32x16& p0, const f32x16& p1, bf16x8 (&pa)[4]) {
    v4u w;
    w.x = cvtpk(p0[0], p0[1]); w.y = cvtpk(p0[2], p0[3]); w.z = cvtpk(p0[4], p0[5]); w.w = cvtpk(p0[6], p0[7]); pa[0] = __builtin_bit_cast(bf16x8, w);
    w.x = cvtpk(p0[8], p0[9]); w.y = cvtpk(p0[10], p0[11]); w.z = cvtpk(p0[12], p0[13]); w.w = cvtpk(p0[14], p0[15]); pa[1] = __builtin_bit_cast(bf16x8, w);
    w.x = cvtpk(p1[0], p1[1]); w.y = cvtpk(p1[2], p1[3]); w.z = cvtpk(p1[4], p1[5]); w.w = cvtpk(p1[6], p1[7]); pa[2] = __builtin_bit_cast(bf16x8, w);
    w.x = cvtpk(p1[8], p1[9]); w.y = cvtpk(p1[10], p1[11]); w.z = cvtpk(p1[12], p1[13]); w.w = cvtpk(p1[14], p1[15]); pa[3] = __builtin_bit_cast(bf16x8, w);
}
#if WOUT_I8
#define MIXPTR(row, col) ((bf16*)(F.ws() + WS_MIX + (size_t)(row) * DM + (col)))
#else
#define MIXPTR(row, col) ((bf16*)(F.ws() + WS_MIX) + (size_t)(row) * DM + (col))
#endif
__device__ __forceinline__ void stage_store(Frame& F, const LAS float* stg, const float* g, float hscale, bf16* dst  ) {
    const int c8 = F.lane & 7;
    float gg[8];
#pragma unroll
    for (int j = 0; j < 8; ++j) gg[j] = g[c8 * 8 + j];
#pragma unroll
    for (int i4 = 0; i4 < 4; ++i4) { const int row = i4 * 8 + (F.lane >> 3);
        const f32x4 a = *(const LAS f32x4*)(stg + row * OST_ROW + c8 * 8), b = *(const LAS f32x4*)(stg + row * OST_ROW + c8 * 8 + 4);
        float ss = (a.x * a.x + a.y * a.y) + (a.z * a.z + a.w * a.w) + (b.x * b.x + b.y * b.y) + (b.z * b.z + b.w * b.w);
        ss += dpp_mov<0xB1>(ss); ss += dpp_mov<0x4E>(ss); ss += dpp_mov<0x141>(ss);
#if WOUT_I8
        const float rs = (127.0f / 8.0f) * __builtin_amdgcn_rsqf(ss * (1.0f / 64.0f) + EPS);
        v2u w; w.x = pack4_i8(a.x * rs, a.y * rs, a.z * rs, a.w * rs); w.y = pack4_i8(b.x * rs, b.y * rs, b.z * rs, b.w * rs);
        *(v2u*)((unsigned char*)dst + (size_t)row * DM + c8 * 8) = w; }
#else
        const float rs = hscale / sqrtf(ss * (1.0f / 64.0f) + EPS);
        v4u w; w.x = pk2(a.x * rs * gg[0], a.y * rs * gg[1]); w.y = pk2(a.z * rs * gg[2], a.w * rs * gg[3]); w.z = pk2(b.x * rs * gg[4], b.y * rs * gg[5]); w.w = pk2(b.z * rs * gg[6], b.w * rs * gg[7]);
        *(v4u*)(dst + (size_t)row * DM + c8 * 8) = w; }
#endif
}

__device__ __forceinline__ void df_unit(Frame& F, int layer, int b, int h, int qb) {
    const int lane = F.lane, r32 = lane & 31, hi = lane >> 5, w = F.wave, tid = F.tid;
    const size_t rowb = (size_t)b * SEQ; const int q0 = qb * 256;
    const bf16* P = (const bf16*)(F.ws() + WS_PROJ);
    const int qpos = q0 + 32 * w + r32, cq = (q0 + 32 * w) >> 6;
    const float slope2 = exp2f(-2.0f * (float)(h + 1)) * LOG2E;
    const float tailb = fminf(12.0f, -log2f(1.0f - exp2f(-slope2)) + 0.125f) + 25.0f;
    LAS float* wsf = (LAS float*)(F.lds + OFF_WSF) + w * 64;
    LAS unsigned* cnt = (LAS unsigned*)(F.lds + OFF_CNT);
    bf16x8 qr[2][2];
#pragma unroll
    for (int i = 0; i < 2; ++i)
#pragma unroll
        for (int d = 0; d < 2; ++d) qr[i][d] = qfrag(P + (rowb + qpos) * INC + C_QDF + h * 64 + i * 32 + d * 16 + hi * 8, 0.17677669529663687f * LOG2E);
    const int ktop = qb * 4 + 3, kcol = C_KDF + h * 64, vcol = C_VDF + h * 64;
    __syncthreads();
#pragma unroll
    for (int j = 0; j < 4; ++j) tile_dma(P, rowb + (size_t)(ktop - j) * 64, kcol, vcol, F.lds + j * KV_BUF, lane, w);
    float smax2;
    { float gq = 0.f, gk = 0.f; const float* pq = F.in[16] + layer * 64; const float* pk = F.in[17] + layer * 64;
      for (int d = 0; d < 64; ++d) { gq = fmaxf(gq, fabsf(pq[d])); gk = fmaxf(gk, fabsf(pk[d])); }
      smax2 = 5.656854249492381f * gq * gk * LOG2E * 1.05f; }
    const float mref = smax2 + slope2 * (float)qpos;
    float l[2] = {0.f, 0.f};
    f32x16 o[2][2];
#pragma unroll
    for (int i = 0; i < 2; ++i)
#pragma unroll
        for (int d = 0; d < 2; ++d) o[i][d] = (f32x16){};
    tile_dma_wait();
    if (tid < 3) cnt[tid] = 0u;
    __syncthreads();
    bool done_w = false;
    for (int it = 0; ; ++it) {
        const int kc = cq - it;
        const LAS unsigned char* Kb = F.lds + ((ktop - cq + it) % KV_RING) * KV_BUF; const LAS unsigned char* Vb = Kb + 8192;
        if (ktop - 4 - it >= 0) tile_dma(P, rowb + (size_t)(ktop - 4 - it) * 64, kcol, vcol, F.lds + ((it + 4) % KV_RING) * KV_BUF, lane, w);
        if (kc >= 0 && !done_w) {
            bf16x8 pa[2][4];
#pragma unroll
            for (int i = 0; i < 2; ++i) {
                const float sc = slope2 * (float)(kc * 64 + 4 * hi) - mref;
                f32x16 p0, p1;
#pragma unroll
                for (int r = 0; r < 16; ++r) { p0[r] = slope2 * C0R(r) + sc; p1[r] = p0[r] + 32.0f * slope2; }
                p0 = __builtin_amdgcn_mfma_f32_32x32x16_bf16(kfrag(Kb, i * 4 + hi, r32), qr[i][0], p0, 0, 0, 0);
                p0 = __builtin_amdgcn_mfma_f32_32x32x16_bf16(kfrag(Kb, i * 4 + 2 + hi, r32), qr[i][1], p0, 0, 0, 0);
                p1 = __builtin_amdgcn_mfma_f32_32x32x16_bf16(kfrag(Kb, i * 4 + hi, r32 + 32), qr[i][0], p1, 0, 0, 0);
                p1 = __builtin_amdgcn_mfma_f32_32x32x16_bf16(kfrag(Kb, i * 4 + 2 + hi, r32 + 32), qr[i][1], p1, 0, 0, 0);
                if (it == 0) {
                    const float qrel = (float)(qpos - kc * 64 - 4 * hi), s2 = 2.0f * slope2;
#pragma unroll
                    for (int r = 0; r < 16; ++r) { const float d0 = C0R(r) - qrel; p0[r] -= s2 * fmaxf(d0, 0.f); p1[r] -= s2 * fmaxf(d0 + 32.0f, 0.f); }
                }
                float ssum = 0.f;
#pragma unroll
                for (int r = 0; r < 16; ++r) { p0[r] = __builtin_amdgcn_exp2f(p0[r]); p1[r] = __builtin_amdgcn_exp2f(p1[r]); ssum += p0[r] + p1[r]; }
                l[i] += ssum;
                pack_p(p0, p1, pa[i]);
            }
            const LAS unsigned char* vp = Vb + ((lane >> 4) & 1) * 32 + (lane & 3) * 8 + (4 * hi + ((lane & 15) >> 2)) * 64;
#pragma unroll
            for (int d0 = 0; d0 < 2; ++d0)
#pragma unroll
                for (int ks = 0; ks < 4; ++ks) { const bf16x8 vf = vfrag(vp, d0, ks);
                    o[0][d0] = __builtin_amdgcn_mfma_f32_32x32x16_bf16(pa[0][ks], vf, o[0][d0], 0, 0, 0);
                    o[1][d0] = __builtin_amdgcn_mfma_f32_32x32x16_bf16(pa[1][ks], vf, o[1][d0], 0, 0, 0); }
            const float lrow = fminf(swap_sum(l[0]), swap_sum(l[1]));
            done_w = __all(slope2 * (float)(kc * 64 - 1 - qpos) + tailb < __builtin_amdgcn_logf(lrow)) != 0;
        }
        if (kc <= 0) done_w = true;
        if (lane == 0 && done_w) __hip_atomic_fetch_add(cnt + (it % 3), 1u, __ATOMIC_RELAXED, __HIP_MEMORY_SCOPE_WORKGROUP);
        if (tid == 0) cnt[(it + 1) % 3] = 0u;
        tile_dma_wait();
        __syncthreads();
        const unsigned c = cnt[it % 3];
        if (c == 8u) break;
    }
    int lane_f = lane; asm volatile("" : "+v"(lane_f)); const int r32f = lane_f & 31, hif = lane_f >> 5;
    const float* lp = F.in[18] + layer * 128; float sa = 0.f, sb = 0.f;
    for (int d = 0; d < 32; ++d) { sa += lp[d] * lp[32 + d]; sb += lp[64 + d] * lp[96 + d]; }
    const float lam_init = 0.8f - 0.6f * expf(-0.3f * (float)layer);
    const float lam = expf(sa) - expf(sb) + lam_init;
    const float l0 = swap_sum(l[0]), l1 = swap_sum(l[1]);
    asm volatile("" ::: "memory");
    if (hif == 0) { wsf[r32f] = 1.0f / l0; wsf[32 + r32f] = -lam / l1; }
    asm volatile("s_waitcnt lgkmcnt(0)" ::: "memory");
    LAS float* stg = (LAS float*)(F.lds + OFF_OST + w * OST_WAVE);
#pragma unroll
    for (int r = 0; r < 16; ++r) { const int row = crow(r, hif); const float a0 = wsf[row], a1 = wsf[32 + row];
        stg[row * OST_ROW + r32f] = o[0][0][r] * a0 + o[1][0][r] * a1; stg[row * OST_ROW + 32 + r32f] = o[0][1][r] * a0 + o[1][1][r] * a1; }
    asm volatile("s_waitcnt lgkmcnt(0)" ::: "memory");
    { Frame F2 = F; F2.lane = lane_f; stage_store(F2, stg, F.in[19] + layer * DM + 768 + h * 64, 1.0f - lam_init, MIXPTR(rowb + q0 + 32 * w, 768 + h * 64)); }
    __syncthreads();
}

__device__ __forceinline__ void sb_unit(Frame& F, int layer, int b, int h, int qb) {
    const int lane = F.lane, r32 = lane & 31, hi = lane >> 5, w = F.wave, tid = F.tid;
    const size_t rowb = (size_t)b * SEQ; const int q0 = qb * 256;
    const bf16* P = (const bf16*)(F.ws() + WS_PROJ);
    const int qpos = q0 + 32 * w + r32, cq = (q0 + 32 * w) >> 6;
    LAS unsigned* cnt = (LAS unsigned*)(F.lds + OFF_CNT);
    bf16x8 qr[4];
#pragma unroll
    for (int d = 0; d < 4; ++d) qr[d] = qfrag(P + (rowb + qpos) * INC + C_QSB + h * 64 + d * 16 + hi * 8, 0.125f * LOG2E);
    bf16x8 U0, U1, ONES;
#pragma unroll
    for (int e = 0; e < 8; ++e) { const int j0 = 8 * (e >> 2) + 4 * hi + (e & 3); U0[e] = (short)((j0 > r32) ? 0x3F80 : 0); U1[e] = (short)((16 + j0 > r32) ? 0x3F80 : 0); ONES[e] = (short)0x3F80; }
    float run = 0.f;
    f32x16 o[2]; o[0] = (f32x16){}; o[1] = (f32x16){};
    const int ktop = qb * 4 + 3, kcol = C_KSB + h * 64, vcol = C_VSB + h * 64;
    __syncthreads();
#pragma unroll
    for (int j = 0; j < 4; ++j) tile_dma(P, rowb + (size_t)(ktop - j) * 64, kcol, vcol, F.lds + j * KV_BUF, lane, w);
    tile_dma_wait();
    if (tid < 3) cnt[tid] = 0u;
    __syncthreads();
    bool done_w = false;
    for (int it = 0; ; ++it) {
        const int kc = cq - it;
        const LAS unsigned char* Kb = F.lds + ((ktop - cq + it) % KV_RING) * KV_BUF; const LAS unsigned char* Vb = Kb + 8192;
        if (ktop - 4 - it >= 0) tile_dma(P, rowb + (size_t)(ktop - 4 - it) * 64, kcol, vcol, F.lds + ((it + 4) % KV_RING) * KV_BUF, lane, w);
        if (kc >= 0 && !done_w) {
            f32x16 p0 = (f32x16){}, p1 = (f32x16){};
#pragma unroll
            for (int d = 0; d < 4; ++d) { p0 = __builtin_amdgcn_mfma_f32_32x32x16_bf16(kfrag(Kb, d * 2 + hi, r32), qr[d], p0, 0, 0, 0);
                                          p1 = __builtin_amdgcn_mfma_f32_32x32x16_bf16(kfrag(Kb, d * 2 + hi, r32 + 32), qr[d], p1, 0, 0, 0); }
            f32x16 m0, m1;
#define SB_SOFTPLUS16(P_, M_) do { float e_[16]; \
                _Pragma("unroll") for (int r = 0; r < 16; ++r) e_[r] = __builtin_amdgcn_exp2f(-fabsf(P_[r])); \
                __builtin_amdgcn_sched_barrier(0); \
                _Pragma("unroll") for (int r = 0; r < 16; ++r) e_[r] = 1.0f + e_[r]; \
                __builtin_amdgcn_sched_barrier(0); \
                _Pragma("unroll") for (int r = 0; r < 16; ++r) e_[r] = __builtin_amdgcn_logf(e_[r]); \
                __builtin_amdgcn_sched_barrier(0); \
                _Pragma("unroll") for (int r = 0; r < 16; ++r) { const float z = P_[r], sp = __builtin_amdgcn_fmed3f(z, 0.f, 3.0e38f) + e_[r]; M_[r] = -sp; P_[r] = z - sp; } \
                __builtin_amdgcn_sched_barrier(0); } while (0)
            SB_SOFTPLUS16(p0, m0); SB_SOFTPLUS16(p1, m1);
#undef SB_SOFTPLUS16
            if (it == 0) {
                const float qrel = (float)(qpos - kc * 64 - 4 * hi);
#pragma unroll
                for (int r = 0; r < 16; ++r) { const bool v0 = C0R(r) < qrel, v1 = C0R(r) + 32.0f < qrel; m0[r] = v0 ? m0[r] : 0.f; p0[r] = v0 ? p0[r] : -1.0e30f; m1[r] = v1 ? m1[r] : 0.f; p1[r] = v1 ? p1[r] : -1.0e30f; }
            }
            float tsum = 0.f;
#pragma unroll
            for (int r = 0; r < 16; ++r) tsum += m0[r] + m1[r];
            bf16x8 lb[4]; pack_p(m0, m1, lb);
            f32x16 b0, b1;
#pragma unroll
            for (int r = 0; r < 16; ++r) { b0[r] = run; b1[r] = run; }
            b0 = __builtin_amdgcn_mfma_f32_32x32x16_bf16(U0, lb[0], b0, 0, 0, 0); b0 = __builtin_amdgcn_mfma_f32_32x32x16_bf16(U1, lb[1], b0, 0, 0, 0);
            b0 = __builtin_amdgcn_mfma_f32_32x32x16_bf16(ONES, lb[2], b0, 0, 0, 0); b0 = __builtin_amdgcn_mfma_f32_32x32x16_bf16(ONES, lb[3], b0, 0, 0, 0);
            b1 = __builtin_amdgcn_mfma_f32_32x32x16_bf16(U0, lb[2], b1, 0, 0, 0); b1 = __builtin_amdgcn_mfma_f32_32x32x16_bf16(U1, lb[3], b1, 0, 0, 0);
#pragma unroll
            for (int r = 0; r < 16; ++r) { p0[r] = __builtin_amdgcn_exp2f(p0[r] + b0[r]); p1[r] = __builtin_amdgcn_exp2f(p1[r] + b1[r]); }
            run += swap_sum(tsum);
            bf16x8 pa[4]; pack_p(p0, p1, pa);
            const LAS unsigned char* vp = Vb + ((lane >> 4) & 1) * 32 + (lane & 3) * 8 + (4 * hi + ((lane & 15) >> 2)) * 64;
#pragma unroll
            for (int d0 = 0; d0 < 2; ++d0)
#pragma unroll
                for (int ks = 0; ks < 4; ++ks) o[d0] = __builtin_amdgcn_mfma_f32_32x32x16_bf16(pa[ks], vfrag(vp, d0, ks), o[d0], 0, 0, 0);
            done_w = __all(run < -40.0f) != 0;
        }
        if (kc <= 0) done_w = true;
        if (lane == 0 && done_w) __hip_atomic_fetch_add(cnt + (it % 3), 1u, __ATOMIC_RELAXED, __HIP_MEMORY_SCOPE_WORKGROUP);
        if (tid == 0) cnt[(it + 1) % 3] = 0u;
        tile_dma_wait();
        __syncthreads();
        const unsigned c = cnt[it % 3];
        if (c == 8u) break;
    }
    int lane_f = lane; asm volatile("" : "+v"(lane_f)); const int r32f = lane_f & 31, hif = lane_f >> 5;
    LAS float* stg = (LAS float*)(F.lds + OFF_OST + w * OST_WAVE);
#pragma unroll
    for (int r = 0; r < 16; ++r) { const int row = crow(r, hif); stg[row * OST_ROW + r32f] = o[0][r]; stg[row * OST_ROW + 32 + r32f] = o[1][r]; }
    asm volatile("s_waitcnt lgkmcnt(0)" ::: "memory");
    { Frame F2 = F; F2.lane = lane_f; stage_store(F2, stg, F.in[19] + layer * DM + 256 + h * 64, 1.0f, MIXPTR(rowb + q0 + 32 * w, 256 + h * 64)); }
    __syncthreads();
}

__device__ __forceinline__ void ch_unit(Frame& F, int layer, int b, int h, int blk) {
    const int lane = F.lane, r32 = lane & 31, hi = lane >> 5, w = F.wave, tid = F.tid;
    const size_t rowb = (size_t)b * SEQ; const int q0 = blk * 256;
    const bf16* P = (const bf16*)(F.ws() + WS_PROJ);
    const int qpos = q0 + 32 * w + r32, cq = (q0 + 32 * w) >> 6;
    LAS float* wsf = (LAS float*)(F.lds + OFF_WSF) + w * 64;
    LAS float* bt = (LAS float*)(F.lds + OFF_BT);
    bf16x8 qr[4];
#pragma unroll
    for (int d = 0; d < 4; ++d) qr[d] = qfrag(P + (rowb + qpos) * INC + C_QCH + (d >> 1) * 128 + 32 * h + (d & 1) * 16 + hi * 8, 0.125f * LOG2E);
    float l = 0.f;
    f32x16 o[2]; o[0] = (f32x16){}; o[1] = (f32x16){};
    const int ktop = blk * 4 + 3, kcol = C_KCH + 32 * h, vcol = C_VCH + h * 64;
    __syncthreads();
#pragma unroll
    for (int j = 0; j < 4; ++j) tile_dma(P, rowb + (size_t)(ktop - j) * 64, kcol, vcol, F.lds + j * KV_BUF, lane, w, 128);
    if (tid < 257) bt[tid] = F.in[15][(layer * 4 + h) * 257 + tid] * LOG2E;
    tile_dma_wait();
    __syncthreads();
    const float bfar = bt[256];
    float mref;
    { float gq = 0.f, gk = 0.f; const float* pq = F.in[13] + layer * 64; const float* pk = F.in[14] + layer * 64;
      for (int d = 0; d < 64; ++d) { gq = fmaxf(gq, fabsf(pq[d])); gk = fmaxf(gk, fabsf(pk[d])); }
      float bm = fmaxf(fmaxf(bt[lane], bt[lane + 64]), fmaxf(bt[lane + 128], bt[lane + 192])); bm = fmaxf(bm, bt[256]);
#pragma unroll
      for (int o_ = 1; o_ < 64; o_ <<= 1) bm = fmaxf(bm, shx(bm, o_, lane));
      mref = 8.0f * gq * gk * LOG2E * 1.05f + bm; }
    for (int it = 0; ; ++it) {
        const int kc = cq - it;
        const LAS unsigned char* Kb = F.lds + ((ktop - cq + it) % KV_RING) * KV_BUF; const LAS unsigned char* Vb = Kb + 8192;
        if (it < 8 && ktop - 4 - it >= 0) tile_dma(P, rowb + (size_t)(ktop - 4 - it) * 64, kcol, vcol, F.lds + ((it + 4) % KV_RING) * KV_BUF, lane, w, 128);
        if (kc >= 0) {
            const bool nearT = it <= 2;
            const float ini = (nearT ? 0.f : bfar) - mref;
            f32x16 p0, p1;
#pragma unroll
            for (int r = 0; r < 16; ++r) { p0[r] = ini; p1[r] = ini; }
#pragma unroll
            for (int d = 0; d < 4; ++d) { p0 = __builtin_amdgcn_mfma_f32_32x32x16_bf16(kfrag(Kb, d * 2 + hi, r32), qr[d], p0, 0, 0, 0);
                                          p1 = __builtin_amdgcn_mfma_f32_32x32x16_bf16(kfrag(Kb, d * 2 + hi, r32 + 32), qr[d], p1, 0, 0, 0); }
            if (nearT) {
                const int qrel = qpos - kc * 64 - 4 * hi + 128;
#pragma unroll
                for (int r = 0; r < 16; ++r) { int i0 = qrel - ((r & 3) + 8 * (r >> 2)); int i1 = i0 - 32;
                    i0 = i0 < 0 ? 0 : (i0 > 256 ? 256 : i0); i1 = i1 < 0 ? 0 : (i1 > 256 ? 256 : i1); p0[r] += bt[i0]; p1[r] += bt[i1]; }
            }
            float ssum = 0.f;
#pragma unroll
            for (int r = 0; r < 16; ++r) { p0[r] = __builtin_amdgcn_exp2f(p0[r]); p1[r] = __builtin_amdgcn_exp2f(p1[r]); ssum += p0[r] + p1[r]; }
            l += ssum;
            bf16x8 pa[4]; pack_p(p0, p1, pa);
            const LAS unsigned char* vp = Vb + ((lane >> 4) & 1) * 32 + (lane & 3) * 8 + (4 * hi + ((lane & 15) >> 2)) * 64;
#pragma unroll
            for (int d0 = 0; d0 < 2; ++d0)
#pragma unroll
                for (int ks = 0; ks < 4; ++ks) o[d0] = __builtin_amdgcn_mfma_f32_32x32x16_bf16(pa[ks], vfrag(vp, d0, ks), o[d0], 0, 0, 0);
        }
        tile_dma_wait();
        __syncthreads();
        if (it == 8) break;
    }
    int lane_f = lane; asm volatile("" : "+v"(lane_f)); const int r32f = lane_f & 31, hif = lane_f >> 5;
    const float lt = swap_sum(l);
    asm volatile("" ::: "memory");
    if (hif == 0) wsf[r32f] = 1.0f / lt;
    asm volatile("s_waitcnt lgkmcnt(0)" ::: "memory");
    LAS float* stg = (LAS float*)(F.lds + OFF_OST + w * OST_WAVE);
#pragma unroll
    for (int r = 0; r < 16; ++r) { const int row = crow(r, hif); const float a = wsf[row]; stg[row * OST_ROW + r32f] = o[0][r] * a; stg[row * OST_ROW + 32 + r32f] = o[1][r] * a; }
    asm volatile("s_waitcnt lgkmcnt(0)" ::: "memory");
    { Frame F2 = F; F2.lane = lane_f; stage_store(F2, stg, F.in[19] + layer * DM + 512 + h * 64, 1.0f, MIXPTR(rowb + q0 + 32 * w, 512 + h * 64)); }
    __syncthreads();
}
#undef C0R
}

__device__ __forceinline__ void sincos_acc(double th, float& s, float& c) {
    double r = th * 0.15915494309189535; r -= __builtin_rint(r);
    double a = r * 6.283185307179586;
    const double k = __builtin_rint(a * 0.6366197723675814);
    const double f = a - k * 1.5707963267948966, f2 = f * f;
    double sp = f * (1.0 + f2 * (-1.0 / 6 + f2 * (1.0 / 120 + f2 * (-1.0 / 5040 + f2 * (1.0 / 362880 + f2 * (-1.0 / 39916800 + f2 * (1.0 / 6227020800.0)))))));
    double cp = 1.0 + f2 * (-0.5 + f2 * (1.0 / 24 + f2 * (-1.0 / 720 + f2 * (1.0 / 40320 + f2 * (-1.0 / 3628800 + f2 * (1.0 / 479001600.0 + f2 * (-1.0 / 87178291200.0)))))));
    const int ki = ((int)k) & 3;
    double ss = sp, cc = cp;
    if (ki == 1) { ss = cp; cc = -sp; } else if (ki == 2) { ss = -sp; cc = -cp; } else if (ki == 3) { ss = -cp; cc = sp; }
    s = (float)ss; c = (float)cc;
}
__device__ __forceinline__ void ssm_prep(Frame& F) {
    const int idx = F.vcu * (NWAVES * 64) + F.tid;
    if (idx < DEPTH * 16 * 64) {
        const int gi = idx >> 6;
        const float lre = F.in[3][idx], lim = F.in[4][idx], dt = expf(F.in[5][gi]);
        float sn, cs; sincos_acc((double)lim * (double)dt, sn, cs);
        const float mag = expf(lre * dt); const float lbr = mag * cs, lbi = mag * sn;
        const float nr = lbr - 1.0f, ni = lbi, den = lre * lre + lim * lim;
        *((f32x4*)(F.ws() + WS_SSMP) + idx) = (f32x4){lbr, lbi, (nr * lre + ni * lim) / den, (ni * lre - nr * lim) / den};
    }
}
constexpr size_t WS_SSMS = WS_SSMY;
constexpr size_t WS_SSMH = WS_SSMY + 4 * MiB;
constexpr size_t WS_WGT = 1 * MiB + 65536;
struct SsmPar { float lbr, lbi; bf16x8 bt[4]; };
__device__ __forceinline__ void ssm_load_par(Frame& F, int layer, int g, SsmPar& p) {
    const int gi = layer * 16 + g, r32 = F.lane & 31, hi = F.lane >> 5;
    const float* pbr = F.in[6]; const float* pbi = F.in[7];
    const f32x4* psp = (const f32x4*)(F.ws() + WS_SSMP);
    const f32x4 own = *(psp + gi * 64 + F.lane + F.vz);
    p.lbr = own.x; p.lbi = own.y;
#pragma unroll
    for (int nh = 0; nh < 2; ++nh) { const int n = 32 * nh + r32;
        const f32x4 sp4 = *(psp + gi * 64 + n + F.vz);
        const f32x4 r0 = *(const f32x4*)(pbr + (gi * 64 + n) * 16 + 8 * hi), r1 = *(const f32x4*)(pbr + (gi * 64 + n) * 16 + 8 * hi + 4);
        const f32x4 i0 = *(const f32x4*)(pbi + (gi * 64 + n) * 16 + 8 * hi), i1 = *(const f32x4*)(pbi + (gi * 64 + n) * 16 + 8 * hi + 4);
        v4u tr, ti;
        tr.x = pk2(sp4.z * r0.x - sp4.w * i0.x, sp4.z * r0.y - sp4.w * i0.y); tr.y = pk2(sp4.z * r0.z - sp4.w * i0.z, sp4.z * r0.w - sp4.w * i0.w);
        tr.z = pk2(sp4.z * r1.x - sp4.w * i1.x, sp4.z * r1.y - sp4.w * i1.y); tr.w = pk2(sp4.z * r1.z - sp4.w * i1.z, sp4.z * r1.w - sp4.w * i1.w);
        ti.x = pk2(sp4.z * i0.x + sp4.w * r0.x, sp4.z * i0.y + sp4.w * r0.y); ti.y = pk2(sp4.z * i0.z + sp4.w * r0.z, sp4.z * i0.w + sp4.w * r0.w);
        ti.z = pk2(sp4.z * i1.x + sp4.w * r1.x, sp4.z * i1.y + sp4.w * r1.y); ti.w = pk2(sp4.z * i1.z + sp4.w * r1.z, sp4.z * i1.w + sp4.w * r1.w);
        p.bt[2 * nh] = __builtin_bit_cast(bf16x8, tr); p.bt[2 * nh + 1] = __builtin_bit_cast(bf16x8, ti); }
}
__device__ __forceinline__ void ssm_x32(Frame& F, const SsmPar& p, const bf16* P, size_t row, int g, fa::f32x16& xr_a, fa::f32x16& xr_b, fa::f32x16& xi_a, fa::f32x16& xi_b) {
    const int r32 = F.lane & 31, hi = F.lane >> 5;
    const bf16x8 ua = *(const bf16x8*)(P + (row + r32) * INC + C_U + g * 16 + 8 * hi);
    const fa::f32x16 z = (fa::f32x16){};
    xr_a = __builtin_amdgcn_mfma_f32_32x32x16_bf16(ua, p.bt[0], z, 0, 0, 0); xi_a = __builtin_amdgcn_mfma_f32_32x32x16_bf16(ua, p.bt[1], z, 0, 0, 0);
    xr_b = __builtin_amdgcn_mfma_f32_32x32x16_bf16(ua, p.bt[2], z, 0, 0, 0); xi_b = __builtin_amdgcn_mfma_f32_32x32x16_bf16(ua, p.bt[3], z, 0, 0, 0);
#pragma unroll
    for (int r = 0; r < 16; ++r) {
        { auto q = __builtin_amdgcn_permlane32_swap(__float_as_uint(xr_a[r]), __float_as_uint(xr_b[r]), false, false); xr_a[r] = __uint_as_float(q[0]); xr_b[r] = __uint_as_float(q[1]); }
        { auto q = __builtin_amdgcn_permlane32_swap(__float_as_uint(xi_a[r]), __float_as_uint(xi_b[r]), false, false); xi_a[r] = __uint_as_float(q[0]); xi_b[r] = __uint_as_float(q[1]); }
    }
}
#define SSM_XR(t) ((((t) >> 2) & 1) ? xr_b[((t) & 3) + 4 * ((t) >> 3)] : xr_a[((t) & 3) + 4 * ((t) >> 3)])
#define SSM_XI(t) ((((t) >> 2) & 1) ? xi_b[((t) & 3) + 4 * ((t) >> 3)] : xi_a[((t) & 3) + 4 * ((t) >> 3)])
__device__ __forceinline__ void ssm_pass1(Frame& F, int layer) {
    const int gw = F.vcu * NWAVES + F.wave, NGW = F.G * NWAVES, n = F.lane;
    const bf16* P = (const bf16*)(F.ws() + WS_PROJ); f32x2* S = (f32x2*)(F.ws() + WS_SSMS);
    const bool xb = (F.G == 256);
    for (int u_ = gw; u_ < BATCH * 64 * 16; u_ += NGW) {
        const int u = xb ? ((((u_ & 2047) >> 8) << 10) + (u_ & 255) + 256 * (u_ >> 11)) : u_;
        const int g = u & 15, c = (u >> 4) & 63, b = u >> 10;
        SsmPar p; ssm_load_par(F, layer, g, p);
        float hr = 0.f, hi = 0.f;
        const size_t row0 = (size_t)b * SEQ + (size_t)c * 64;
#pragma nounroll
        for (int blk = 0; blk < 2; ++blk) {
            fa::f32x16 xr_a, xr_b, xi_a, xi_b; ssm_x32(F, p, P, row0 + blk * 32, g, xr_a, xr_b, xi_a, xi_b);
#pragma unroll
            for (int t = 0; t < 32; ++t) { const float nhr = p.lbr * hr - p.lbi * hi + SSM_XR(t), nhi = p.lbr * hi + p.lbi * hr + SSM_XI(t); hr = nhr; hi = nhi; }
        }
        S[(size_t)u * 64 + n] = (f32x2){hr, hi};
    }
}
constexpr int S2_Y2 = 0, S2_Y2ROW = 264  , S2_HST = 34816, S2_OUT = 34816, S2_OUTROW = 260  ;
static_assert(S2_Y2 + 64 * S2_Y2ROW * 2 <= S2_HST && S2_HST + 8 * 4096 <= RING_BYTES && S2_OUT + 64 * S2_OUTROW * 4 <= RING_BYTES, "ssm pass-2 LDS map");
__device__ __forceinline__ void ssm_pass2_unit(Frame& F, int layer, int b, int c) {
    const int lane = F.lane, w = F.wave, n = lane;
    const bf16* P = (const bf16*)(F.ws() + WS_PROJ);
    const size_t row0 = (size_t)b * SEQ + (size_t)c * 64;
    LAS unsigned* hst = (LAS unsigned*)(F.lds + S2_HST + w * 4096);
    LAS bf16* y2 = (LAS bf16*)(F.lds + S2_Y2);
    __syncthreads();
#pragma unroll
    for (int gg = 0; gg < 2; ++gg) {
        const int g = 2 * w + gg, gi = layer * 16 + g;
        SsmPar p; ssm_load_par(F, layer, g, p);
        bf16x8 ca[4];
        { const int pr = lane & 15, a4 = lane >> 4; const float* pcr = F.in[8]; const float* pci = F.in[9];
#pragma unroll
          for (int ks = 0; ks < 4; ++ks) { const f32x4 cr = *(const f32x4*)(pcr + (gi * 16 + pr) * 64 + 16 * ks + 4 * a4), ci = *(const f32x4*)(pci + (gi * 16 + pr) * 64 + 16 * ks + 4 * a4);
              v4u t; t.x = pk2(cr.x, -ci.x); t.y = pk2(cr.y, -ci.y); t.z = pk2(cr.z, -ci.z); t.w = pk2(cr.w, -ci.w); ca[ks] = __builtin_bit_cast(bf16x8, t); } }
        float hr = 0.f, hi = 0.f;
        {
            float ar = p.lbr, ai = p.lbi;
#pragma unroll
            for (int k = 0; k < 6; ++k) { const float tr = ar * ar - ai * ai, ti = 2.0f * ar * ai; ar = tr; ai = ti; }
            const f32x2* Sg = (const f32x2*)(F.ws() + WS_SSMS) + ((size_t)(b * 64) * 16 + g) * 64 + n + F.vz;
#pragma nounroll
            for (int c0 = 0; c0 < c; c0 += 32) {
                f32x2 sv[32];
#pragma unroll
                for (int k = 0; k < 32; ++k) { const int cc = (c0 + k < 64) ? c0 + k : 63; sv[k] = Sg[(size_t)cc * 1024]; }
#pragma unroll
                for (int k = 0; k < 32; ++k) { const bool ok = c0 + k < c; const float nr = ar * hr - ai * hi + sv[k].x, ni = ar * hi + ai * hr + sv[k].y; hr = ok ? nr : hr; hi = ok ? ni : hi; }
            }
        }
        const f32x4 dsk = *(const f32x4*)(F.in[10] + layer * 256 + g * 16 + 4 * (lane >> 4));
#pragma nounroll
        for (int blk2 = 0; blk2 < 2; ++blk2) {
          fa::f32x16 xr_a, xr_b, xi_a, xi_b; ssm_x32(F, p, P, row0 + blk2 * 32, g, xr_a, xr_b, xi_a, xi_b);
#pragma unroll
          for (int half = 0; half < 2; ++half) {
            const int blk = blk2 * 2 + half;
#pragma unroll
            for (int k = 0; k < 16; ++k) { const int t = half * 16 + k; const float nhr = p.lbr * hr - p.lbi * hi + SSM_XR(t), nhi = p.lbr * hi + p.lbi * hr + SSM_XI(t); hr = nhr; hi = nhi;
                hst[k * 64 + n] = fa::cvtpk(hr, hi); }
            asm volatile("s_waitcnt lgkmcnt(0)" ::: "memory");
            f32x4 acc = (f32x4){0.f, 0.f, 0.f, 0.f};
#pragma unroll
            for (int ks = 0; ks < 4; ++ks) { const bf16x8 hb = *(const LAS bf16x8*)(hst + (lane & 15) * 64 + 16 * ks + 4 * (lane >> 4));
                acc = __builtin_amdgcn_mfma_f32_16x16x32_bf16(ca[ks], hb, acc, 0, 0, 0); }
            const int tok = blk * 16 + (lane & 15), ch = g * 16 + 4 * (lane >> 4);
            const v2u uu = *((const v2u*)(P + (row0 + tok) * INC + C_U + ch));
            float y[4]; y[0] = acc[0] + dsk.x * lo_bf(uu.x); y[1] = acc[1] + dsk.y * hi_bf(uu.x); y[2] = acc[2] + dsk.z * lo_bf(uu.y); y[3] = acc[3] + dsk.w * hi_bf(uu.y);
#pragma unroll
            for (int r = 0; r < 4; ++r) { const float a = 0.7978845608028654f * (y[r] + 0.044715f * y[r] * y[r] * y[r]); y[r] = y[r] * __builtin_amdgcn_rcpf(1.0f + __builtin_amdgcn_exp2f(-2.8853900817779268f * a)); }
            v2u o2; o2.x = pk2(y[0], y[1]); o2.y = pk2(y[2], y[3]);
            *(LAS v2u*)(y2 + tok * S2_Y2ROW + ch) = o2;
            asm volatile("s_waitcnt lgkmcnt(0)" ::: "memory");
          }
        }
    }
    __syncthreads();
    const int r32 = lane & 31, hi5 = lane >> 5;
    fa::f32x16 d0 = (fa::f32x16){}, d1 = (fa::f32x16){};
    const bf16* WT = (const bf16*)(F.ws() + WS_WGT) + (size_t)layer * 65536 + (size_t)(32 * w + r32) * 256;
#pragma unroll 8
    for (int ks = 0; ks < 16; ++ks) {
        const bf16x8 bw = *(const bf16x8*)(WT + 16 * ks + 8 * hi5);
        const bf16x8 a0 = *(const LAS bf16x8*)(y2 + r32 * S2_Y2ROW + 16 * ks + 8 * hi5), a1 = *(const LAS bf16x8*)(y2 + (32 + r32) * S2_Y2ROW + 16 * ks + 8 * hi5);
        d0 = __builtin_amdgcn_mfma_f32_32x32x16_bf16(a0, bw, d0, 0, 0, 0); d1 = __builtin_amdgcn_mfma_f32_32x32x16_bf16(a1, bw, d1, 0, 0, 0);
    }
    const int j = 32 * w + r32; const float bg = F.in[12][layer * 256 + j];
    float gate0[16], gate1[16];
#pragma unroll
    for (int r = 0; r < 16; ++r) { const int t = fa::crow(r, hi5);
        const float ya = bf2f(y2[t * S2_Y2ROW + j]), yb = bf2f(y2[(32 + t) * S2_Y2ROW + j]);
        gate0[r] = ya * __builtin_amdgcn_rcpf(1.0f + __builtin_amdgcn_exp2f(-1.4426950408889634f * (d0[r] + bg))); gate1[r] = yb * __builtin_amdgcn_rcpf(1.0f + __builtin_amdgcn_exp2f(-1.4426950408889634f * (d1[r] + bg))); }
    __syncthreads();
    LAS float* ost = (LAS float*)(F.lds + S2_OUT);
#pragma unroll
    for (int r = 0; r < 16; ++r) { const int t = fa::crow(r, hi5); ost[t * S2_OUTROW + j] = gate0[r]; ost[(32 + t) * S2_OUTROW + j] = gate1[r]; }
    __syncthreads();
    { const int tok = F.tid >> 3, c8 = F.tid & 7; bf16* dst = (bf16*)(F.ws() + WS_MIX) + (row0 + tok) * DM;
#pragma unroll
      for (int hd = 0; hd < 4; ++hd) {
          const f32x4 a = *(const LAS f32x4*)(ost + tok * S2_OUTROW + hd * 64 + c8 * 8), bq = *(const LAS f32x4*)(ost + tok * S2_OUTROW + hd * 64 + c8 * 8 + 4);
          float ss = (a.x * a.x + a.y * a.y) + (a.z * a.z + a.w * a.w) + (bq.x * bq.x + bq.y * bq.y) + (bq.z * bq.z + bq.w * bq.w);
          ss += dpp_mov<0xB1>(ss); ss += dpp_mov<0x4E>(ss); ss += dpp_mov<0x141>(ss);
#if WOUT_I8
          const float rs = (127.0f / 8.0f) * __builtin_amdgcn_rsqf(ss * (1.0f / 64.0f) + EPS);
          v2u wv; wv.x = pack4_i8(a.x * rs, a.y * rs, a.z * rs, a.w * rs); wv.y = pack4_i8(bq.x * rs, bq.y * rs, bq.z * rs, bq.w * rs);
          *(v2u*)((unsigned char*)(F.ws() + WS_MIX) + (size_t)(row0 + tok) * DM + hd * 64 + c8 * 8) = wv; } }
#else
          const float rs = 1.0f / sqrtf(ss * (1.0f / 64.0f) + EPS);
          const float* gp = F.in[19] + layer * DM + hd * 64 + c8 * 8;
          v4u wv; wv.x = pk2(a.x * rs * gp[0], a.y * rs * gp[1]); wv.y = pk2(a.z * rs * gp[2], a.w * rs * gp[3]); wv.z = pk2(bq.x * rs * gp[4], bq.y * rs * gp[5]); wv.w = pk2(bq.z * rs * gp[6], bq.w * rs * gp[7]);
          *(v4u*)(dst + hd * 64 + c8 * 8) = wv; } }
#endif
}

constexpr int NS = 10, NSTEPS = 1 + DEPTH * NS + 1;
#ifndef PROBE
#define PROBE 0
#endif
#define NREP(x) ((PROBE == (x)) ? 2 : 1)
#define NREPG(k) ((PROBE == 1 || PROBE == (k)) ? 2 : 1)
#define DUMMY_OUT ((float*)(F.ws() + 704 * MiB))
#define IN(k) (lo <= (k) && (k) < hi)
#define REFRESH (refresh(F, lds0), true)
#define SEAM(k) do { if (IN(k) && IN((k) + 1)) xcd_barrier(lds0, F.wave0); } while (0)
#define SEAML(k, cond) do { if (IN(k) && IN((k) + 1)) { if ((cond) && F.MISC[12] != 0u) xcd_local_barrier(lds0, F.wave0); else xcd_barrier(lds0, F.wave0); } } while (0)
__device__ __forceinline__ void layer_body(Frame& F, const int layer, LAS unsigned char* const lds0, const int lo, const int hi) {
        const int s0 = 1 + layer * NS; const bool moe = (layer & 1) != 0; const int mi = layer >> 1;
        const float* xcur = (layer == 0) ? F.in[0] : nullptr;
        if (layer != 0) { for (int rep = 0; rep < ((layer != 2) ? NREP(21) : 1); ++rep) if (REFRESH && IN(s0)) { norm_phase(F, xcur, layer == 2, F.in[1] + layer * DM, false, nullptr, 0, true, WIN_I8 ? 2 : 0, WS_RSM); } SEAML(s0, true); }
#if WIN_I8
        for (int rep = 0; rep < NREPG(10); ++rep) if (REFRESH && IN(s0 + 1)) { pg8::Order S; S.init(NTOK / 256, INC / 256, F.G, F.bx, F.ws() + WS_H, F.ws() + WS_WIN + (size_t)layer * INC * DM, DM / 2, 0, nullptr);
            pg8::EpiProjI8 E{(bf16*)(F.ws() + WS_PROJ), INC, F.in[13] + layer * 64, F.in[14] + layer * 64, F.in[16] + layer * 64, F.in[17] + layer * 64, (const float*)(F.ws() + WS_RSM), (const float*)(F.ws() + WS_SWIN) + layer * INC};
            pg8::gemm_phase<pg8::EpiProjI8, 2>(F.lds, F.tid, DM / 2, S, E); } SEAML(s0 + 1, true);
#else
        for (int rep = 0; rep < NREPG(10); ++rep) if (REFRESH && IN(s0 + 1)) { pg8::Order S; S.init(NTOK / 256, INC / 256, F.G, F.bx, (const bf16*)(F.ws() + WS_H), (const bf16*)(F.ws() + WS_WIN) + (size_t)layer * INC * DM, DM, 0, nullptr);
            pg8::EpiProj E{(bf16*)(F.ws() + WS_PROJ), INC, F.in[13] + layer * 64, F.in[14] + layer * 64, F.in[16] + layer * 64, F.in[17] + layer * 64, nullptr, nullptr}; pg8::gemm_phase<pg8::EpiProj>(F.lds, F.tid, DM, S, E); } SEAM(s0 + 1);
#endif
        for (int rep = 0; rep < NREP(2); ++rep) if (REFRESH && IN(s0 + 3)) {
            for (int rep7 = 0; rep7 < NREP(3) + NREP(7) - 1; ++rep7) ssm_pass1(F, layer);
            refresh(F, lds0);
            if (F.wave0 >= 4) __builtin_amdgcn_s_setprio(1);
            const bool bal = (F.G == 256);
            int t_lo = 0, t_hi = 0;
            if (bal) { const int jb = F.vcu & 31; float sumdf = 0.f, mydf = 0.f, before = 0.f;
#define DF_LIGHT(j_) (2.06f * (((j_) & 1) ? 3.5f : fminf((float)(4 * ((j_) >> 1) + 4), 7.6f)) + 8.0f)
#define DF_HEAVY(j_) (2.06f * (((j_) & 1) ? fminf((float)(64 - 4 * ((j_) >> 1)), 29.0f) : (float)(64 - 4 * ((j_) >> 1))) + 8.0f)
#define DF_COST(jj_) (DF_HEAVY(jj_) + ((((jj_) & 1) || (jj_) > 4) ? DF_LIGHT(jj_) : 0.f) + ((((jj_) & 1) && (jj_) >= 27) ? DF_LIGHT(31 - (jj_)) : 0.f))
                for (int jj = 0; jj < 32; ++jj) sumdf += DF_COST(jj);
                const float ctot = 64.0f * 10.0f + 64.0f * 17.0f, T = (ctot + sumdf) * (1.0f / 32.0f);
                float sumb = 0.f;
                for (int jj = 0; jj < 32; ++jj) { const float bj = fmaxf(T - DF_COST(jj), 0.f); if (jj < jb) before += bj; if (jj == jb) mydf = bj; sumb += bj; }
                const float sc = ctot / sumb, lo_b = before * sc, hi_b = (before + mydf) * sc;
                float c = 0.f;
                for (int u = 0; u < 128; ++u) { const float co = u < 64 ? 10.0f : 17.0f, mid = c + 0.5f * co; if (mid <= lo_b) t_lo = u + 1; if (mid <= hi_b) t_hi = u + 1; c += co; }
                if (jb == 31) t_hi = 128;
#undef DF_COST
#undef DF_HEAVY
#undef DF_LIGHT
            }
            const int sb_lo = bal ? t_lo : F.vcu, sb_hi = bal ? (t_hi < 64 ? t_hi : 64) : 512, ch_lo = bal ? (t_lo > 64 ? t_lo : 64) : F.vcu, ch_hi = bal ? t_hi : 512, ust = bal ? 1 : F.G;
            for (int rep5 = 0; rep5 < NREP(5); ++rep5) for (int u = sb_lo; u < sb_hi; u += ust) { const int idx = bal ? u : (u & 31) + 32 * (u >> 8); fa::sb_unit(F, layer, bal ? (F.vcu >> 5) : ((u & 255) >> 5), idx >> 4, idx & 15); }
            refresh(F, lds0);
            for (int rep4 = 0; rep4 < NREP(4); ++rep4) for (int u = F.vcu, k = 0; bal ? (k < 3) : (u < 512); u += F.G, ++k) {
                int bb, hh, qq; bool on = true;
                if (bal) { const int j = F.vcu & 31; bb = F.vcu >> 5;
                    if (k == 0) { hh = 3 - (j & 1); qq = 15 - (j >> 1); }
                    else if (k == 1) { hh = 1 - (j & 1); qq = j >> 1; on = (j & 1) || j > 4; }
                    else { hh = 1; qq = (31 - j) >> 1; on = (j & 1) && j >= 27; } }
                else { const int j = u & 31, i = u >> 8; bb = (u & 255) >> 5; hh = (i == 0 ? 3 : 1) - (j & 1); qq = (i == 0) ? 15 - (j >> 1) : (j >> 1); }
                if (on) fa::df_unit(F, layer, bb, hh, qq); }
            refresh(F, lds0);
            for (int rep6 = 0; rep6 < NREP(6); ++rep6) for (int u = ch_lo; u < ch_hi; u += ust) { const int idx = bal ? u - 64 : (u & 31) + 32 * (u >> 8); fa::ch_unit(F, layer, bal ? (F.vcu >> 5) : ((u & 255) >> 5), idx >> 4, idx & 15); }
            refresh(F, lds0);
            __syncthreads();
            __builtin_amdgcn_s_setprio(0);
            moe_convert_half(F, layer >> 1, layer & 1);
#if DENSE_UP_I8
            if (layer == 0) dense_up_convert(F);
#endif
        } SEAML(s0 + 3, true);
        for (int rep = 0; rep < NREP(3); ++rep) if (REFRESH && IN(s0 + 4)) { for (int u = F.vcu; u < BATCH * 64; u += F.G) { const bool xb = (F.G == 256); ssm_pass2_unit(F, layer, xb ? ((u & 255) >> 5) : (u >> 6), xb ? ((u & 31) + 32 * (u >> 8)) : (u & 63)); } } SEAML(s0 + 4, layer != 0);
#if WOUT_I8
        for (int rep = NREPG(11) - 1; rep >= 0; --rep) if (REFRESH && IN(s0 + 5)) { pg8::Order S; S.init(NTOK / 256, DM / 256, F.G, F.bx, F.ws() + WS_MIX, F.ws() + WS_WOUT + (size_t)layer * DM * DM, DM / 2, 0, nullptr);
            pg8::EpiResBf16I8 E{xcur, (const bf16*)(F.ws() + WS_XRES), rep ? (bf16*)DUMMY_OUT : (bf16*)(F.ws() + WS_XRES), DM, 1.0f, (const float*)(F.ws() + WS_SWOUT) + layer * DM}; pg8::gemm_phase<pg8::EpiResBf16I8, 2>(F.lds, F.tid, DM / 2, S, E); } SEAML(s0 + 5, true);
#else
        for (int rep = NREPG(11) - 1; rep >= 0; --rep) if (REFRESH && IN(s0 + 5)) { pg8::Order S; S.init(NTOK / 256, DM / 256, F.G, F.bx, (const bf16*)(F.ws() + WS_MIX), (const bf16*)(F.ws() + WS_WOUT) + (size_t)layer * DM * DM, DM, 0, nullptr);
            pg8::EpiResBf16 E{xcur, (const bf16*)(F.ws() + WS_XRES), rep ? (bf16*)DUMMY_OUT : (bf16*)(F.ws() + WS_XRES), DM, 1.0f, nullptr}; pg8::gemm_phase<pg8::EpiResBf16>(F.lds, F.tid, DM, S, E); } SEAM(s0 + 5);
#endif
        for (int rep = 0; rep < (moe ? 1 : NREP(21)); ++rep) if (REFRESH && IN(s0 + 6)) { norm_phase(F, nullptr, false, F.in[21] + layer * DM, moe, F.in[25] + (size_t)mi * DM * NE, mi, true, moe ? (MOE_FP8 ? 1 : 0) : (DENSE_UP_I8 ? 2 : (DENSE_FP8 ? 1 : 0))); } SEAML(s0 + 6, !moe);
        if (!moe) {
#if DENSE_UP_I8
            for (int rep = 0; rep < NREPG(12); ++rep) if (REFRESH && IN(s0 + 7)) { pg8::Order S; S.init(NTOK / 256, 2 * DFF / 256, F.G, F.bx, F.ws() + WS_H, F.ws() + WS_WFUP + (size_t)mi * 2 * DFF * DM, DM / 2, 0, nullptr);
                const float ag = __uint_as_float(__hip_atomic_load((unsigned*)(F.ctl() + CW_AMAX + 64 * (2 * mi)), __ATOMIC_RELAXED, __HIP_MEMORY_SCOPE_AGENT)), au = __uint_as_float(__hip_atomic_load((unsigned*)(F.ctl() + CW_AMAX + 64 * (2 * mi + 1)), __ATOMIC_RELAXED, __HIP_MEMORY_SCOPE_AGENT));
#if DENSE_DN_FP8
                pg8::EpiSwiGLUI8F8 E{(bf16*)(F.ws() + WS_HID), DFF, (const float*)(F.ws() + WS_RS), ag * (1.0f / 127.0f), au * (1.0f / 127.0f)}; pg8::gemm_phase<pg8::EpiSwiGLUI8F8, 2>(F.lds, F.tid, DM / 2, S, E); } SEAML(s0 + 7, true);
            for (int rep = NREPG(13) - 1; rep >= 0; --rep) if (REFRESH && IN(s0 + 8)) { pg8::Order S; S.init(NTOK / 256, DM / 256, F.G, F.bx, F.ws() + WS_HID, F.ws() + WS_WFDN + (size_t)mi * DM * DFF, DFF / 2, 0, nullptr); S.rev = 1;
                pg8::EpiResBf16 E{nullptr, (const bf16*)(F.ws() + WS_XRES), rep ? (bf16*)DUMMY_OUT : (bf16*)(F.ws() + WS_XRES), DM, INV8, nullptr}; pg8::gemm_phase<pg8::EpiResBf16, 1>(F.lds, F.tid, DFF / 2, S, E); } SEAML(s0 + 8, true);
#else
                pg8::EpiSwiGLUI8 E{(bf16*)(F.ws() + WS_HID), DFF, (const float*)(F.ws() + WS_RS), ag * (1.0f / 127.0f), au * (1.0f / 127.0f)}; pg8::gemm_phase<pg8::EpiSwiGLUI8, 2>(F.lds, F.tid, DM / 2, S, E); } SEAML(s0 + 7, true);
            for (int rep = NREPG(13) - 1; rep >= 0; --rep) if (REFRESH && IN(s0 + 8)) { pg8::Order S; S.init(NTOK / 256, DM / 256, F.G, F.bx, (const bf16*)(F.ws() + WS_HID), (const bf16*)(F.ws() + WS_WFDN) + (size_t)mi * DM * DFF, DFF, 0, nullptr); S.rev = 1;
                pg8::EpiResBf16 E{nullptr, (const bf16*)(F.ws() + WS_XRES), rep ? (bf16*)DUMMY_OUT : (bf16*)(F.ws() + WS_XRES), DM, 1.0f, nullptr}; pg8::gemm_phase<pg8::EpiResBf16>(F.lds, F.tid, DFF, S, E); } SEAML(s0 + 8, true);
#endif
#elif DENSE_FP8
            for (int rep = 0; rep < NREPG(12); ++rep) if (REFRESH && IN(s0 + 7)) { pg8::Order S; S.init(NTOK / 256, 2 * DFF / 256, F.G, F.bx, F.ws() + WS_H, F.ws() + WS_WFUP + (size_t)mi * 2 * DFF * DM, DM / 2, 0, nullptr);
                pg8::EpiSwiGLU8 E{F.ws() + WS_HID, DFF, INV8}; pg8::gemm_phase<pg8::EpiSwiGLU8, true>(F.lds, F.tid, DM / 2, S, E); } SEAM(s0 + 7);
            for (int rep = NREPG(13) - 1; rep >= 0; --rep) if (REFRESH && IN(s0 + 8)) { pg8::Order S; S.init(NTOK / 256, DM / 256, F.G, F.bx, F.ws() + WS_HID, F.ws() + WS_WFDN + (size_t)mi * DM * DFF, DFF / 2, 0, nullptr);
                pg8::EpiResBf16 E{nullptr, (const bf16*)(F.ws() + WS_XRES), rep ? (bf16*)DUMMY_OUT : (bf16*)(F.ws() + WS_XRES), DM, INV8, nullptr}; pg8::gemm_phase<pg8::EpiResBf16, true>(F.lds, F.tid, DFF / 2, S, E); } SEAM(s0 + 8);
#else
            for (int rep = 0; rep < NREPG(12); ++rep) if (REFRESH && IN(s0 + 7)) { pg8::Order S; S.init(NTOK / 256, 2 * DFF / 256, F.G, F.bx, (const bf16*)(F.ws() + WS_H), (const bf16*)(F.ws() + WS_WFUP) + (size_t)mi * 2 * DFF * DM, DM, 0, nullptr);
                pg8::EpiSwiGLU E{(bf16*)(F.ws() + WS_HID), DFF}; pg8::gemm_phase<pg8::EpiSwiGLU>(F.lds, F.tid, DM, S, E); } SEAM(s0 + 7);
            for (int rep = NREPG(13) - 1; rep >= 0; --rep) if (REFRESH && IN(s0 + 8)) { pg8::Order S; S.init(NTOK / 256, DM / 256, F.G, F.bx, (const bf16*)(F.ws() + WS_HID), (const bf16*)(F.ws() + WS_WFDN) + (size_t)mi * DM * DFF, DFF, 0, nullptr); S.rev = 1;
                pg8::EpiResBf16 E{nullptr, (const bf16*)(F.ws() + WS_XRES), rep ? (bf16*)DUMMY_OUT : (bf16*)(F.ws() + WS_XRES), DM, 1.0f, nullptr}; pg8::gemm_phase<pg8::EpiResBf16>(F.lds, F.tid, DFF, S, E); } SEAM(s0 + 8);
#endif
        } else {
            if (REFRESH && IN(s0 + 7)) { moe_scatter(F, mi); } SEAM(s0 + 7);
#if MOE_FP8
            for (int rep = 0; rep < NREPG(14); ++rep) if (REFRESH && IN(s0 + 8)) { const int nT = moe_tile_table(F, mi);
                pg8::Order S; S.init(nT, 2 * DFE / 256, F.G, F.bx, F.ws() + WS_HPERM, F.ws() + WS_WMUP + (size_t)mi * WMUP_LAYER, DM / 2, (size_t)2 * DFE * DM, (const LAS int*)(F.lds + MISC_OFF + 32 * 4)); S.gmap = (const int*)(F.ws() + WS_SLOTTOK);
                pg8::EpiSwiGLU8 E{F.ws() + WS_HIDP, DFE, INV8}; pg8::gemm_phase<pg8::EpiSwiGLU8, 1, true, true>(F.lds, F.tid, DM / 2, S, E); } SEAM(s0 + 8);
            for (int rep = 0; rep < NREPG(15); ++rep) if (REFRESH && IN(s0 + 9)) { const int nT = moe_tile_table(F, mi);
                const int nunits = nT * (DM / 256), Gg = (layer == 1 && F.G == 256 && (hi - lo) > 1 && rep == 0) ? 8 * ((nunits + 39) / 40) : F.G;
                if (F.bx < Gg) {
                    pg8::Order S; S.init(nT, DM / 256, Gg, F.bx, F.ws() + WS_HIDP, F.ws() + WS_WMDN + (size_t)mi * WMDN_LAYER, DFE / 2, (size_t)DM * DFE, (const LAS int*)(F.lds + MISC_OFF + 32 * 4)); S.rev = 1;
                    pg8::EpiBf16 E{(bf16*)(F.ws() + WS_YPERM), DM, INV8}; pg8::gemm_phase<pg8::EpiBf16, true>(F.lds, F.tid, DFE / 2, S, E);
                } else { refresh(F, lds0); moe_convert_half(F, 1, 0); } } SEAM(s0 + 9);
#else
            for (int rep = 0; rep < NREPG(14); ++rep) if (REFRESH && IN(s0 + 8)) { const int nT = moe_tile_table(F, mi);
                pg8::Order S; S.init(nT, 2 * DFE / 256, F.G, F.bx, (const bf16*)(F.ws() + WS_HPERM), (const bf16*)(F.ws() + WS_WMUP), DM, (size_t)2 * DFE * DM * 2, (const LAS int*)(F.lds + MISC_OFF + 32 * 4));
                pg8::EpiSwiGLU E{(bf16*)(F.ws() + WS_HIDP), DFE}; pg8::gemm_phase<pg8::EpiSwiGLU>(F.lds, F.tid, DM, S, E); } SEAM(s0 + 8);
            for (int rep = 0; rep < NREPG(15); ++rep) if (REFRESH && IN(s0 + 9)) { const int nT = moe_tile_table(F, mi);
                pg8::Order S; S.init(nT, DM / 256, F.G, F.bx, (const bf16*)(F.ws() + WS_HIDP), (const bf16*)(F.ws() + WS_WMDN), DFE, (size_t)DM * DFE * 2, (const LAS int*)(F.lds + MISC_OFF + 32 * 4));
                pg8::EpiBf16 E{(bf16*)(F.ws() + WS_YPERM), DM, 1.0f}; pg8::gemm_phase<pg8::EpiBf16>(F.lds, F.tid, DFE, S, E); } SEAM(s0 + 9);
#endif
        }
    }

struct Args { const float* in[29]; float* out; unsigned char* ws; int step_lo, step_hi; };
__global__ void __launch_bounds__(NWAVES * 64, 2) hybrid_fwd(Args args) {
    extern __shared__ __attribute__((aligned(16))) unsigned char lds[];
    Frame F;
    LAS unsigned char* const lds0 = (LAS unsigned char*)lds;
    F.wave0 = __builtin_amdgcn_readfirstlane((int)threadIdx.x >> 6);
    refresh(F, lds0);
    for (int u = F.tid; u < (LDS_BYTES - LDSCTL_OFF) / 4; u += NWAVES * 64) ((LAS unsigned*)(F.lds + LDSCTL_OFF))[u] = 0u;
    __syncthreads();
    if (F.tid == 0) { LAS unsigned long long* pt = (LAS unsigned long long*)(F.lds + LDSCTL_OFF);
#pragma unroll
        for (int k = 0; k < 29; ++k) pt[k] = (unsigned long long)args.in[k];
        pt[29] = (unsigned long long)args.out; pt[30] = (unsigned long long)args.ws; }
    __syncthreads();
    const int lo = args.step_lo, hi = args.step_hi;
    const bool single = (hi - lo) > 1;
    if (single && F.tid == 0) __hip_atomic_fetch_or((unsigned*)(args.ws + WS_CTL) + CW_LG + 64 * (blockIdx.x % 8), 1u << xb_xcc_id(), __ATOMIC_RELAXED, __HIP_MEMORY_SCOPE_AGENT);
    if (single) (void)xcd_barrier_post((unsigned*)(args.ws + WS_CTL) + CW_BAR, (volatile LAS unsigned*)(lds0 + MISC_OFF) + 8);
    if (REFRESH && IN(0)) { prologue_convert(F); ssm_prep(F);
#if DENSE_UP_I8
        dense_amax(F);
#endif
#if WIN_I8
        win_amax(F);
#if WOUT_I8
        wout_amax(F);
#endif
        if (single) xcd_barrier(lds0, F.wave0);
        refresh(F, lds0);
        win_convert(F);
#if WOUT_I8
        wout_convert(F);
#endif
        norm_phase(F, F.in[0], false, F.in[1], false, nullptr, 0, true, 2, WS_RSM);
#else
        norm_phase(F, F.in[0], false, F.in[1], false, nullptr, 0, true, 0);
#endif
    } SEAM(0);
    if (single) { refresh(F, lds0);
        if (F.tid == 0) { unsigned all = 0u, ok = (F.G == 256) ? 1u : 0u;
            for (int g = 0; g < 8; ++g) { const unsigned m = __hip_atomic_load((unsigned*)(F.ctl() + CW_LG + 64 * g), __ATOMIC_RELAXED, __HIP_MEMORY_SCOPE_AGENT); if (m == 0u || (m & (m - 1u)) != 0u || (all & m) != 0u) ok = 0u; all |= m; }
            F.MISC[12] = ok; }
        __syncthreads(); }

    for (int layer = 0; layer < DEPTH; ++layer) layer_body(F, layer, lds0, lo, hi);
    for (int rep = 0; rep < NREP(21); ++rep) if (REFRESH && IN(NSTEPS - 1)) { norm_phase(F, nullptr, true, nullptr, false, nullptr, 0, false, 0); }
#undef IN
#undef SEAM
#undef REFRESH
}

extern "C" void kernel_launch(void* const* d_in, const int* in_sizes, int n_in, void* d_out, int out_size, void* d_ws, size_t ws_size, hipStream_t stream) {
    static int grid = 0;
    if (grid == 0) {
        if (n_in != 29 || out_size != NTOK * DM || ws_size < WS_END) { fprintf(stderr, "kernel_launch: unexpected problem (n_in %d, out %d, ws %zu)\n", n_in, out_size, ws_size); grid = -1; return; }
        int dev = 0, cus = 0, per_cu = 0;
        if (hipGetDevice(&dev) != hipSuccess || hipDeviceGetAttribute(&cus, hipDeviceAttributeMultiprocessorCount, dev) != hipSuccess) { grid = -1; return; }
        if (hipFuncSetAttribute((const void*)hybrid_fwd, hipFuncAttributeMaxDynamicSharedMemorySize, LDS_BYTES) != hipSuccess) { grid = -1; return; }
        if (hipOccupancyMaxActiveBlocksPerMultiprocessor(&per_cu, (const void*)hybrid_fwd, NWAVES * 64, LDS_BYTES) != hipSuccess || per_cu < 1) { fprintf(stderr, "kernel_launch: occupancy query says %d\n", per_cu); }
        (void)hipGetLastError();
        grid = cus;
    }
    if (grid < 0) return;
    Args a{};
    for (int i = 0; i < 29; ++i) a.in[i] = (const float*)d_in[i];
    a.out = (float*)d_out; a.ws = (unsigned char*)d_ws;
#ifdef MK_STEPWISE
    hipMemsetAsync((char*)d_ws + WS_CTL, 0, CTL_ZERO_BYTES, stream);
    for (int s = 0; s < NSTEPS; ++s) { a.step_lo = s; a.step_hi = s + 1; hipLaunchKernelGGL(hybrid_fwd, dim3(grid), dim3(NWAVES * 64), LDS_BYTES, stream, a); }
#else
    hipMemsetAsync((char*)d_ws + WS_CTL, 0, CTL_ZERO_BYTES, stream);
    a.step_lo = 0; a.step_hi = NSTEPS;
    hipLaunchKernelGGL(hybrid_fwd, dim3(grid), dim3(NWAVES * 64), LDS_BYTES, stream, a);
#endif
}
```
